# Optimizing an MI355X kernel written in HIP

```python
import math
import jax, jax.numpy as jnp
from jax import lax
import numpy as np

D_MODEL = 2048
BATCH = 4
SEQ = 4096
DEPTH = 2

D_PLE = 256
D_FF = 5632
MLA_HEADS = 8
MLA_NOPE = 128
MLA_ROPE = 64
MLA_QK = MLA_NOPE + MLA_ROPE
MLA_V = 128
Q_LORA = 512
KV_LORA = 256
ROPE_THETA = 10000.0
CONV_CH = 512
CONV_WIDTH = 31
SB_HEADS = 4
SB_HEAD_DIM = 128
D_MIX = MLA_HEADS * MLA_V + CONV_CH + SB_HEADS * SB_HEAD_DIM
D_SB_QKV = 3 * SB_HEADS * SB_HEAD_DIM
D_IN = Q_LORA + KV_LORA + MLA_ROPE + 2 * CONV_CH + D_SB_QKV
IN_SPLITS = (Q_LORA, Q_LORA + KV_LORA, Q_LORA + KV_LORA + MLA_ROPE,
             Q_LORA + KV_LORA + MLA_ROPE + 2 * CONV_CH)
BLOCK_Q = 128
EPS = 1e-6
NEG = -1e30

kernel_name = "hymba_mla_conformer_stickbreak_macaron"


def rmsnorm(x, g):
    xf = x.astype(jnp.float32)
    y = xf * lax.rsqrt(jnp.mean(xf * xf, axis=-1, keepdims=True) + EPS)
    return (y * g.astype(jnp.float32)).astype(x.dtype)


def layernorm(x, g, b):
    xf = x.astype(jnp.float32)
    mu = jnp.mean(xf, axis=-1, keepdims=True)
    var = jnp.mean(jnp.square(xf - mu), axis=-1, keepdims=True)
    y = (xf - mu) * lax.rsqrt(var + EPS)
    return (y * g.astype(jnp.float32) + b.astype(jnp.float32)).astype(x.dtype)


def swiglu(h, w_in, w_out):
    a, u = jnp.split(h @ w_in, 2, axis=-1)
    return (jax.nn.silu(a) * u) @ w_out


def rope(x, positions):
    d = x.shape[-1]
    inv_freq = ROPE_THETA ** (-jnp.arange(0, d, 2, dtype=jnp.float32) / d)
    ang = positions.astype(jnp.float32)[..., None] * inv_freq
    cos = jnp.cos(ang)[:, :, None, :].astype(x.dtype)
    sin = jnp.sin(ang)[:, :, None, :].astype(x.dtype)
    x1, x2 = jnp.split(x, 2, axis=-1)
    return jnp.concatenate([x1 * cos - x2 * sin, x1 * sin + x2 * cos], axis=-1)


def query_blocks(q):
    b, s, h, d = q.shape
    return q.reshape(b, s // BLOCK_Q, BLOCK_Q, h, d).transpose(1, 0, 2, 3, 4)


def merge_blocks(o):
    nb, b, bq, h, d = o.shape
    return o.transpose(1, 0, 2, 3, 4).reshape(b, nb * bq, h * d)


def causal_softmax_attention(q, k, v):
    s_len = q.shape[1]
    scale = q.shape[-1] ** -0.5
    kpos = jnp.arange(s_len)

    def one_block(args):
        qb, blk = args
        qpos = blk * BLOCK_Q + jnp.arange(BLOCK_Q)
        s = jnp.einsum('bqhd,bkhd->bhqk', qb, k, preferred_element_type=jnp.float32) * scale
        s = jnp.where(kpos[None, :] <= qpos[:, None], s, NEG)
        w = jax.nn.softmax(s, axis=-1)
        return jnp.einsum('bhqk,bkhd->bqhd', w.astype(v.dtype), v)

    out = lax.map(one_block, (query_blocks(q), jnp.arange(s_len // BLOCK_Q)))
    return merge_blocks(out)


def stick_breaking_attention(q, k, v):
    s_len = q.shape[1]
    scale = q.shape[-1] ** -0.5
    kpos = jnp.arange(s_len)

    def one_block(args):
        qb, blk = args
        qpos = blk * BLOCK_Q + jnp.arange(BLOCK_Q)
        z = jnp.einsum('bqhd,bkhd->bhqk', qb, k, preferred_element_type=jnp.float32) * scale
        strict = kpos[None, :] < qpos[:, None]
        log_beta = jax.nn.log_sigmoid(z)
        log_keep = jnp.where(strict, jax.nn.log_sigmoid(-z), 0.0)
        after = lax.cumsum(log_keep, axis=log_keep.ndim - 1, reverse=True) - log_keep
        w = jnp.where(strict, jnp.exp(log_beta + after), 0.0)
        return jnp.einsum('bhqk,bkhd->bqhd', w.astype(v.dtype), v)

    out = lax.map(one_block, (query_blocks(q), jnp.arange(s_len // BLOCK_Q)))
    return merge_blocks(out)


def conformer_conv(u, w_dw, b_dw, g_ln, b_ln, w_pw):
    a, gate = jnp.split(u, 2, axis=-1)
    g = a * jax.nn.sigmoid(gate)
    y = lax.conv_general_dilated(
        g, w_dw[:, None, :].astype(g.dtype), window_strides=(1,),
        padding=[(CONV_WIDTH - 1, 0)], dimension_numbers=('NWC', 'WIO', 'NWC'),
        feature_group_count=CONV_CH) + b_dw.astype(g.dtype)
    y = layernorm(y, g_ln, b_ln)
    return jax.nn.silu(y) @ w_pw


def setup_inputs(seed: int = 0) -> dict:
    key = jax.random.key(seed)
    ks = iter(jax.random.split(key, 40))

    def w(shape, fan_in):
        return jax.random.normal(next(ks), shape, jnp.float32) * (fan_in ** -0.5)

    def gain(n):
        return 1.0 + 0.02 * jax.random.normal(next(ks), (DEPTH, n), jnp.float32)

    def bias(n):
        return 0.01 * jax.random.normal(next(ks), (DEPTH, n), jnp.float32)

    x = jax.random.normal(next(ks), (BATCH, SEQ, D_MODEL), jnp.float32)
    p = jax.random.normal(next(ks), (DEPTH, BATCH, SEQ, D_PLE), jnp.float32)
    positions = jnp.broadcast_to(jnp.arange(SEQ, dtype=jnp.int32), (BATCH, SEQ))
    return {
        "x": x, "p": p, "positions": positions,
        "g_ff1_pre": gain(D_MODEL),
        "w_ff1_in": w((DEPTH, D_MODEL, 2 * D_FF), D_MODEL),
        "w_ff1_out": w((DEPTH, D_FF, D_MODEL), D_FF),
        "g_ff1_post": gain(D_MODEL),
        "g_mix_pre": gain(D_MODEL),
        "w_in": w((DEPTH, D_MODEL, D_IN), D_MODEL),
        "g_cq": gain(Q_LORA),
        "w_uq": w((DEPTH, Q_LORA, MLA_HEADS * MLA_QK), Q_LORA),
        "g_ckv": gain(KV_LORA),
        "w_ukv": w((DEPTH, KV_LORA, MLA_HEADS * (MLA_NOPE + MLA_V)), KV_LORA),
        "w_dw": w((DEPTH, CONV_WIDTH, CONV_CH), CONV_WIDTH),
        "b_dw": bias(CONV_CH),
        "g_conv_ln": gain(CONV_CH),
        "b_conv_ln": bias(CONV_CH),
        "w_pw": w((DEPTH, CONV_CH, CONV_CH), CONV_CH),
        "w_out": w((DEPTH, D_MIX, D_MODEL), D_MIX),
        "g_mix_post": gain(D_MODEL),
        "g_ff2_pre": gain(D_MODEL),
        "w_ff2_in": w((DEPTH, D_MODEL, 2 * D_FF), D_MODEL),
        "w_ff2_out": w((DEPTH, D_FF, D_MODEL), D_FF),
        "g_ff2_post": gain(D_MODEL),
        "g_ple_pre": gain(D_MODEL),
        "w_ple_gate": w((DEPTH, D_MODEL, D_MODEL), D_MODEL),
        "w_ple_proj": w((DEPTH, D_PLE, D_MODEL), D_PLE),
        "g_ple_post": gain(D_MODEL),
    }


def reference(x, p, positions,
              g_ff1_pre, w_ff1_in, w_ff1_out, g_ff1_post,
              g_mix_pre, w_in, g_cq, w_uq, g_ckv, w_ukv,
              w_dw, b_dw, g_conv_ln, b_conv_ln, w_pw, w_out, g_mix_post,
              g_ff2_pre, w_ff2_in, w_ff2_out, g_ff2_post,
              g_ple_pre, w_ple_gate, w_ple_proj, g_ple_post):
    b, s, _ = x.shape
    for i in range(DEPTH):
        f = swiglu(rmsnorm(x, g_ff1_pre[i]), w_ff1_in[i], w_ff1_out[i])
        x = x + 0.5 * rmsnorm(f, g_ff1_post[i])

        h = rmsnorm(x, g_mix_pre[i])
        u = h @ w_in[i]
        c_q, c_kv, k_r, u_conv, u_sb = jnp.split(u, IN_SPLITS, axis=-1)

        q = (rmsnorm(c_q, g_cq[i]) @ w_uq[i]).reshape(b, s, MLA_HEADS, MLA_QK)
        q_nope, q_rope = jnp.split(q, [MLA_NOPE], axis=-1)
        q = jnp.concatenate([q_nope, rope(q_rope, positions)], axis=-1)
        kv = (rmsnorm(c_kv, g_ckv[i]) @ w_ukv[i]).reshape(b, s, MLA_HEADS, MLA_NOPE + MLA_V)
        k_nope, v = jnp.split(kv, [MLA_NOPE], axis=-1)
        k_rope = rope(k_r[:, :, None, :], positions)
        k = jnp.concatenate(
            [k_nope, jnp.broadcast_to(k_rope, (b, s, MLA_HEADS, MLA_ROPE))], axis=-1)
        o_mla = causal_softmax_attention(q, k, v)

        o_conv = conformer_conv(u_conv, w_dw[i], b_dw[i], g_conv_ln[i], b_conv_ln[i], w_pw[i])

        qkv = u_sb.reshape(b, s, 3, SB_HEADS, SB_HEAD_DIM)
        o_sb = stick_breaking_attention(qkv[:, :, 0], qkv[:, :, 1], qkv[:, :, 2])

        mix = jnp.concatenate([o_mla, o_conv, o_sb], axis=-1) @ w_out[i]
        x = x + rmsnorm(mix, g_mix_post[i])

        f = swiglu(rmsnorm(x, g_ff2_pre[i]), w_ff2_in[i], w_ff2_out[i])
        x = x + 0.5 * rmsnorm(f, g_ff2_post[i])

        gate = jax.nn.sigmoid(rmsnorm(x, g_ple_pre[i]) @ w_ple_gate[i])
        e = p[i].astype(x.dtype) @ w_ple_proj[i]
        x = x + rmsnorm(gate * e, g_ple_post[i])
    return x
```

```cpp
#include <hip/hip_runtime.h>
#include <hip/hip_cooperative_groups.h>
#include <cstdio>
#include <cstdint>
namespace cg = cooperative_groups;
namespace pg8 {
#define PG8_LAS __attribute__((address_space(3)))
typedef unsigned short bf16_t;
typedef short bf16x8 __attribute__((ext_vector_type(8)));
typedef float f32x4 __attribute__((ext_vector_type(4)));
typedef unsigned u32x4 __attribute__((ext_vector_type(4)));
constexpr int BM = 256, BK = 64, HALF = 128, HTB = HALF * BK * 2  , STAGE_BYTES = 8 * HTB, NXCD = 8, WGM = 4;

__host__ __device__ __forceinline__ int lds_byte(int r, int c) { const int st = (r >> 4) * 2 + (c >> 5), rr = r & 15, cc = c & 31, ob = rr * 64 + cc * 2; return st * 1024 + (ob ^ (((ob >> 9) & 1) << 5)); }
__host__ __device__ __forceinline__ void stage_rc(int b, int& R, int& C) { const int st = b / 1024, sb = b % 1024, swz = sb ^ (((sb >> 9) & 1) << 5); R = (st >> 1) * 16 + swz / 64; C = (st & 1) * 32 + (swz % 64) / 2; }
__host__ __device__ __forceinline__ int perm32(int rho) { const int n = rho >> 4, i = rho & 15; return 8 * (i >> 2) + 4 * n + (i & 3); }

struct Unit { int pm, pn; };
struct Gemm { const bf16_t* A; const bf16_t* Bt; int M, N, K; };

struct StaticOrder {
    int nM, nN, nwg, G, c;
    __host__ __device__ void init(int M, int N, int G_, int c_) { nM = M / BM; nN = N / BM; nwg = nM * nN; G = G_; c = c_; }
    __host__ __device__ bool next(int i, Unit& u) const {
        const long L = (long)i * G + c; if (L >= nwg) return false;
        int wgid = (int)L; { const int q = nwg / NXCD, r = nwg % NXCD, xcd = wgid % NXCD, off = wgid / NXCD; wgid = (xcd < r ? xcd * (q + 1) : r * (q + 1) + (xcd - r) * q) + off; }
        const int nig = WGM * nN, gid = wgid / nig, fm = gid * WGM, gsz = (nM - fm) < WGM ? (nM - fm) : WGM;
        u.pm = fm + ((wgid % nig) % gsz); u.pn = (wgid % nig) / gsz; return true;
    }
    __device__ __forceinline__ void a_ready(const Unit&) const {}
    __device__ __forceinline__ void done(const Unit&) const {}
};
__device__ __forceinline__ unsigned cvt_pk_bf16(float lo, float hi) { unsigned r; asm volatile("v_cvt_pk_bf16_f32 %0, %1, %2" : "=v"(r) : "v"(lo), "v"(hi)); return r; }
typedef float f32x2 __attribute__((ext_vector_type(2)));
template <class Epi, class Sched, bool ALIGN_EPI = false, bool SP2 = false>
__device__ __forceinline__ void gemm_phase(PG8_LAS unsigned char* lds, const Gemm g, const Sched& S, const Epi& E) {
    int tid_o = threadIdx.x; asm volatile("" : "+v"(tid_o));
    const int tid = tid_o, wid = __builtin_amdgcn_readfirstlane(tid >> 6), lane = tid & 63, wr = wid >> 2, wc = wid & 3, fr = lane & 15, fq = lane >> 4;
    const int K = g.K, nt = K / BK;
    unsigned voffA[2], voffB[2];
#pragma unroll
    for (int i = 0; i < 2; ++i) { int R, C; stage_rc(tid * 16 + i * 8192, R, C); const int Rb = Epi::PERM ? ((R & ~31) + perm32(R & 31)) : R;
        voffA[i] = (unsigned)(R * K + C) * 2u; voffB[i] = (unsigned)(Rb * K + C) * 2u; }
    const size_t kstep = (size_t)(BK * 2);
    const size_t hstep = (size_t)HALF * K * 2;
    const size_t tstep = 2 * hstep;
    const unsigned ldsw = (unsigned)wid * 1024u;
    const int aoff = lds_byte(wr * 64 + fr, fq * 8), boff = lds_byte(wc * 32 + fr, fq * 8);
#define PG8_SA(b, h) (((b) * 2 + (h)) * HTB)
#define PG8_SB(b, h) ((4 + (b) * 2 + (h)) * HTB)
#define PG8_STAGE(bufoff, gbase, voff) do { _Pragma("unroll") for (int _i = 0; _i < 2; ++_i) \
        __builtin_amdgcn_global_load_lds((const unsigned*)((const char*)(gbase) + (voff)[_i]), (PG8_LAS unsigned*)(lds + (bufoff) + ldsw + _i * 8192), 16, 0, 0); } while (0)
#define PG8_LDA(dst, b, h) do { _Pragma("unroll") for (int m = 0; m < 4; ++m) _Pragma("unroll") for (int k = 0; k < 2; ++k) dst[m][k] = *(const PG8_LAS bf16x8*)(lds + PG8_SA(b, h) + aoff + m * 2048 + k * 1024); } while (0)
#define PG8_LDB(dst, b, h) do { _Pragma("unroll") for (int n = 0; n < 2; ++n) _Pragma("unroll") for (int k = 0; k < 2; ++k) dst[n][k] = *(const PG8_LAS bf16x8*)(lds + PG8_SB(b, h) + boff + n * 2048 + k * 1024); } while (0)
#define PG8_MMA(ai, bj, At, Bt) do { __builtin_amdgcn_s_setprio(1); _Pragma("unroll") for (int m = 0; m < 4; ++m) _Pragma("unroll") for (int n = 0; n < 2; ++n) _Pragma("unroll") for (int k = 0; k < 2; ++k) \
        acc[ai][bj][m][n] = __builtin_amdgcn_mfma_f32_16x16x32_bf16(Bt[n][k], At[m][k], acc[ai][bj][m][n], 0, 0, 0); __builtin_amdgcn_s_setprio(0); } while (0)
#define PG8_WAIT_V(n) asm volatile("s_waitcnt vmcnt(" #n ")" ::: "memory")
#define PG8_WAIT_L(n) asm volatile("s_waitcnt lgkmcnt(" #n ")" ::: "memory")
#define PG8_BAR __builtin_amdgcn_s_barrier()
#define PG8_SCHED __builtin_amdgcn_sched_barrier(0)
    Unit cur, nxt; int ui = 0;
    if (!S.next(0, cur)) return;
    f32x4 acc[2][2][4][2];
#pragma unroll
    for (int a = 0; a < 2; ++a)
#pragma unroll
        for (int b = 0; b < 2; ++b)
#pragma unroll
            for (int m = 0; m < 4; ++m)
#pragma unroll
                for (int n = 0; n < 2; ++n) acc[a][b][m][n] = (f32x4){0.f, 0.f, 0.f, 0.f};
    bf16x8 At[4][2], B0[2][2], B1[2][2];
    const char* cA = (const char*)g.A + (size_t)cur.pm * tstep; const char* cB = (const char*)g.Bt + (size_t)cur.pn * tstep;
    S.a_ready(cur);
    if constexpr (SP2) {
        PG8_STAGE(PG8_SB(0, 0), cB, voffB); PG8_STAGE(PG8_SB(0, 1), cB + hstep, voffB); PG8_STAGE(PG8_SA(0, 0), cA, voffA); PG8_STAGE(PG8_SA(0, 1), cA + hstep, voffA);
        if (wr == 1) PG8_BAR;
        PG8_WAIT_V(2); PG8_BAR;
        PG8_STAGE(PG8_SB(1, 0), cB + kstep, voffB); PG8_STAGE(PG8_SA(1, 0), cA + kstep, voffA); PG8_STAGE(PG8_SB(1, 1), cB + hstep + kstep, voffB);
        PG8_WAIT_V(6); PG8_BAR;
    } else {
        PG8_STAGE(PG8_SB(0, 0), cB, voffB); PG8_STAGE(PG8_SA(0, 0), cA, voffA); PG8_STAGE(PG8_SB(0, 1), cB + hstep, voffB); PG8_STAGE(PG8_SA(0, 1), cA + hstep, voffA);
        if (wr == 1) PG8_BAR;
        PG8_WAIT_V(4); PG8_BAR;
        PG8_STAGE(PG8_SB(1, 0), cB + kstep, voffB); PG8_STAGE(PG8_SA(1, 0), cA + kstep, voffA); PG8_STAGE(PG8_SB(1, 1), cB + hstep + kstep, voffB);
        PG8_WAIT_V(6); PG8_BAR;
    }
    for (;;) {
        const bool has_next = S.next(ui + 1, nxt);
        const char* nA = has_next ? (const char*)g.A + (size_t)nxt.pm * tstep : cA; const char* nB = has_next ? (const char*)g.Bt + (size_t)nxt.pn * tstep : cB;
        for (int t = 0; t < nt; t += 2) {
            const bool last = (t == nt - 2);
            const char* a1 = cA + (size_t)(t + 1) * kstep;
            const char* a2 = last ? nA : cA + (size_t)(t + 2) * kstep; const char* b2 = last ? nB : cB + (size_t)(t + 2) * kstep;
            const char* a3 = a2 + kstep; const char* b3 = b2 + kstep;
            if (last && has_next) S.a_ready(nxt);
            if constexpr (SP2) {
            PG8_LDB(B0, 0, 0); PG8_LDB(B1, 0, 1); PG8_SCHED; PG8_LDA(At, 0, 0); PG8_STAGE(PG8_SA(1, 1), a1 + hstep, voffA);
            PG8_WAIT_V(8); PG8_WAIT_L(0); PG8_BAR; PG8_MMA(0, 0, At, B0); PG8_MMA(0, 1, At, B1); PG8_BAR; PG8_SCHED;
            PG8_LDA(At, 0, 1); PG8_STAGE(PG8_SB(0, 0), b2, voffB); PG8_STAGE(PG8_SB(0, 1), b2 + hstep, voffB); PG8_STAGE(PG8_SA(0, 0), a2, voffA);
            PG8_WAIT_V(8); PG8_WAIT_L(0); PG8_BAR; PG8_MMA(1, 0, At, B0); PG8_MMA(1, 1, At, B1); PG8_BAR; PG8_SCHED;
            PG8_LDB(B0, 1, 0); PG8_LDB(B1, 1, 1); PG8_SCHED; PG8_LDA(At, 1, 0); PG8_STAGE(PG8_SA(0, 1), a2 + hstep, voffA);
            PG8_WAIT_V(8); PG8_WAIT_L(0); PG8_BAR; PG8_MMA(0, 0, At, B0); PG8_MMA(0, 1, At, B1); PG8_BAR; PG8_SCHED;
            PG8_LDA(At, 1, 1); PG8_STAGE(PG8_SB(1, 0), b3, voffB); PG8_STAGE(PG8_SB(1, 1), b3 + hstep, voffB); PG8_STAGE(PG8_SA(1, 0), a3, voffA);
            PG8_WAIT_V(8); PG8_WAIT_L(0); PG8_BAR; PG8_MMA(1, 0, At, B0); PG8_MMA(1, 1, At, B1); PG8_BAR; PG8_SCHED;
            } else {
            PG8_LDB(B0, 0, 0); PG8_SCHED; PG8_LDA(At, 0, 0); PG8_STAGE(PG8_SA(1, 1), a1 + hstep, voffA);
            PG8_WAIT_L(8); PG8_BAR; PG8_WAIT_L(0); PG8_MMA(0, 0, At, B0); PG8_BAR; PG8_SCHED;
            PG8_LDB(B1, 0, 1); PG8_STAGE(PG8_SB(0, 0), b2, voffB);
            PG8_BAR; PG8_WAIT_L(0); PG8_MMA(0, 1, At, B1); PG8_BAR;
            PG8_LDA(At, 0, 1); PG8_STAGE(PG8_SA(0, 0), a2, voffA);
            PG8_BAR; PG8_WAIT_L(0); PG8_MMA(1, 0, At, B0); PG8_BAR; PG8_SCHED;
            PG8_STAGE(PG8_SB(0, 1), b2 + hstep, voffB);
            PG8_WAIT_V(6); PG8_BAR; PG8_MMA(1, 1, At, B1); PG8_BAR;
            PG8_LDB(B0, 1, 0); PG8_SCHED; PG8_LDA(At, 1, 0); PG8_STAGE(PG8_SA(0, 1), a2 + hstep, voffA);
            PG8_WAIT_L(8); PG8_BAR; PG8_WAIT_L(0); PG8_MMA(0, 0, At, B0); PG8_BAR; PG8_SCHED;
            PG8_LDB(B1, 1, 1); PG8_STAGE(PG8_SB(1, 0), b3, voffB);
            PG8_BAR; PG8_WAIT_L(0); PG8_MMA(0, 1, At, B1); PG8_BAR;
            PG8_LDA(At, 1, 1); PG8_STAGE(PG8_SA(1, 0), a3, voffA);
            PG8_BAR; PG8_WAIT_L(0); PG8_MMA(1, 0, At, B0); PG8_BAR; PG8_SCHED;
            PG8_STAGE(PG8_SB(1, 1), b3 + hstep, voffB);
            PG8_WAIT_V(6); PG8_BAR; PG8_MMA(1, 1, At, B1); PG8_BAR;
            }
        }
        if constexpr (ALIGN_EPI) { if (wr == 0) PG8_BAR; }
        if constexpr (!Epi::AFTER_DRAIN) { E(acc, cur, wr, wc, fr, fq); S.done(cur); }
        if (!has_next) break;
#pragma unroll
        for (int a = 0; a < 2; ++a)
#pragma unroll
            for (int b = 0; b < 2; ++b)
#pragma unroll
                for (int m = 0; m < 4; ++m)
#pragma unroll
                    for (int n = 0; n < 2; ++n) acc[a][b][m][n] = (f32x4){0.f, 0.f, 0.f, 0.f};
        cur = nxt; cA = nA; cB = nB; ++ui;
        if constexpr (ALIGN_EPI) { if (wr == 1) PG8_BAR; }
    }
    PG8_WAIT_V(0);
    if constexpr (!ALIGN_EPI) { if (wr == 0) PG8_BAR; }
    PG8_BAR;
    if constexpr (Epi::AFTER_DRAIN) { E.fused(acc, cur, wr, wc, fr, fq, lds, wid, lane); S.done(cur); }
#undef PG8_SA
#undef PG8_SB
#undef PG8_STAGE
#undef PG8_LDA
#undef PG8_LDB
#undef PG8_MMA
#undef PG8_WAIT_V
#undef PG8_WAIT_L
#undef PG8_BAR
#undef PG8_SCHED
}
}

#define LAS __attribute__((address_space(3)))
using pg8::bf16_t; using pg8::f32x4; using pg8::u32x4; using pg8::Unit; using pg8::cvt_pk_bf16;
typedef short bf16x8 __attribute__((ext_vector_type(8)));
typedef float f32x16 __attribute__((ext_vector_type(16)));
typedef unsigned u32x2 __attribute__((ext_vector_type(2)));
typedef short v4i16_t __attribute__((ext_vector_type(4)));

constexpr int M_TOK = 16384, SEQ = 4096, DM = 2048, DFF = 5632, NWIN = 3584;
constexpr float EPS = 1e-6f, LOG2E = 1.4426950408889634f;
constexpr float QSCALE = 0.07216878364870322f * 1.4426950408889634f;
constexpr float SBSCALE = 0.08838834764831845f * 1.4426950408889634f;

constexpr size_t MiB = 1u << 20;
constexpr size_t WS_CTL = 0, WS_RSTD = 512 * 1024;
constexpr size_t WS_W = 1 * MiB, W_LAYER = 167 * MiB;
constexpr size_t WO_FF1IN = 0, WO_FF1OUT = 44 * MiB, WO_IN = 66 * MiB, WO_UQ = 80 * MiB, WO_UKV = 82 * MiB, WO_PW = 83 * MiB,
                 WO_OUT = 84 * MiB, WO_FF2IN = 92 * MiB, WO_FF2OUT = 136 * MiB, WO_GATE = 158 * MiB, WO_PROJ = 166 * MiB;
static_assert(WO_PROJ + 2048 * 256 * 2 <= W_LAYER, "weights map");
constexpr size_t WS_HID = 335 * MiB;
constexpr size_t WS_CQ = WS_HID, WS_CKV = WS_HID + 16 * MiB, WS_GLU = WS_HID + 24 * MiB, WS_SBQ = WS_HID + 40 * MiB, WS_SBK = WS_HID + 56 * MiB,
                 WS_SBV = WS_HID + 72 * MiB, WS_KR = WS_HID + 88 * MiB, WS_SSQ = WS_HID + 90 * MiB, WS_MIX = WS_HID + 91 * MiB;
static_assert(WS_MIX + 64 * MiB <= WS_HID + 176 * MiB && WS_SBV - WS_SBK == WS_SBK - WS_SBQ, "hid overlay");
constexpr size_t WS_F = 511 * MiB;
constexpr size_t WS_Q = WS_F, WS_KN = WS_F + 48 * MiB, WS_V = WS_F + 80 * MiB, WS_CV = WS_F + 112 * MiB;
constexpr size_t WS_XN = 639 * MiB;
constexpr size_t WS_PB = 703 * MiB;
constexpr size_t WS_COS = 719 * MiB, WS_SIN = 721 * MiB;
constexpr size_t WS_EB = 723 * MiB;
constexpr size_t WS_END = 787 * MiB;

constexpr int LDS_BYTES = 147456;
constexpr int MISC_OFF = 131072;
constexpr int CW_BAR = 4096;

__device__ __forceinline__ int otid() { int t = threadIdx.x; asm volatile("" : "+v"(t)); return t; }
__device__ __forceinline__ float wave_sum(float v) {
#pragma unroll
    for (int o = 1; o < 64; o <<= 1) v += __shfl_xor(v, o);
    return v;
}
__device__ __forceinline__ float fexp2(float x) { return __builtin_amdgcn_exp2f(x); }
__device__ __forceinline__ float frcp(float x) { return __builtin_amdgcn_rcpf(x); }
__device__ __forceinline__ float sigmoidf_(float x) { return frcp(1.0f + fexp2(-x * LOG2E)); }
__device__ __forceinline__ void st8(bf16_t* p, f32x4 v0, f32x4 v1) {
    u32x4 w; w.x = cvt_pk_bf16(v0[0], v0[1]); w.y = cvt_pk_bf16(v0[2], v0[3]); w.z = cvt_pk_bf16(v1[0], v1[1]); w.w = cvt_pk_bf16(v1[2], v1[3]);
    *(u32x4*)p = w;
}
__device__ __forceinline__ void st4(bf16_t* p, f32x4 v) { u32x2 w; w.x = cvt_pk_bf16(v[0], v[1]); w.y = cvt_pk_bf16(v[2], v[3]); *(u32x2*)p = w; }
__device__ __forceinline__ float dot4(f32x4 a) { return (a[0] * a[0] + a[1] * a[1]) + (a[2] * a[2] + a[3] * a[3]); }

#define EPI_ROWS for (int ai = 0; ai < 2; ++ai) _Pragma("unroll") for (int m = 0; m < 4; ++m)
#define LOAD_RS(rsv, ptr, row0) float rsv[2][4]; _Pragma("unroll") for (int ai = 0; ai < 2; ++ai) _Pragma("unroll") for (int m = 0; m < 4; ++m) rsv[ai][m] = (ptr)[(row0) + ai * 128 + m * 16];
struct EpiSwiglu {
    static constexpr bool PERM = true, AFTER_DRAIN = false;
    bf16_t* H; const float* rstd;
    __device__ __forceinline__ void operator()(const f32x4 (&acc)[2][2][4][2], const Unit& u, int wr, int wc, int fr, int fq) const {
        asm volatile("" : "+v"(fr), "+v"(fq));
        const int row0 = u.pm * 256 + wr * 64 + fr, col = u.pn * 128 + wc * 32 + 8 * fq;
        LOAD_RS(rsv, rstd, row0)
#pragma unroll
        EPI_ROWS { const int row = row0 + ai * 128 + m * 16; const float rs = rsv[ai][m]; f32x4 o[2];
#pragma unroll
            for (int n = 0; n < 2; ++n) { const f32x4 a = acc[ai][0][m][n] * rs, g = acc[ai][1][m][n] * rs;
#pragma unroll
                for (int e = 0; e < 4; ++e) o[n][e] = a[e] * sigmoidf_(a[e]) * g[e]; }
            st8(H + (size_t)row * DFF + col, o[0], o[1]); }
    }
};
struct EpiF32 {
    static constexpr bool PERM = true, AFTER_DRAIN = false;
    float* O; int ldc;
    __device__ __forceinline__ void operator()(const f32x4 (&acc)[2][2][4][2], const Unit& u, int wr, int wc, int fr, int fq) const {
        asm volatile("" : "+v"(fr), "+v"(fq));
        const int row0 = u.pm * 256 + wr * 64 + fr, col = u.pn * 256 + wc * 32 + 8 * fq;
#pragma unroll
        EPI_ROWS { float* p = O + (size_t)(row0 + ai * 128 + m * 16) * ldc + col;
#pragma unroll
            for (int bj = 0; bj < 2; ++bj) { *(f32x4*)(p + bj * 128) = acc[ai][bj][m][0]; *(f32x4*)(p + bj * 128 + 4) = acc[ai][bj][m][1]; } }
    }
};
struct EpiBf {
    static constexpr bool PERM = true, AFTER_DRAIN = false;
    bf16_t* O; int ldc;
    __device__ __forceinline__ void operator()(const f32x4 (&acc)[2][2][4][2], const Unit& u, int wr, int wc, int fr, int fq) const {
        asm volatile("" : "+v"(fr), "+v"(fq));
        const int row0 = u.pm * 256 + wr * 64 + fr, col = u.pn * 256 + wc * 32 + 8 * fq;
#pragma unroll
        EPI_ROWS { bf16_t* p = O + (size_t)(row0 + ai * 128 + m * 16) * ldc + col;
#pragma unroll
            for (int bj = 0; bj < 2; ++bj) st8(p + bj * 128, acc[ai][bj][m][0], acc[ai][bj][m][1]); }
    }
};
struct EpiGate {
    static constexpr bool PERM = true, AFTER_DRAIN = false;
    bf16_t* O; const bf16_t* Eb; const float* rstd;
    __device__ __forceinline__ void operator()(const f32x4 (&acc)[2][2][4][2], const Unit& u, int wr, int wc, int fr, int fq) const {
        asm volatile("" : "+v"(fr), "+v"(fq));
        const int row0 = u.pm * 256 + wr * 64 + fr, col = u.pn * 256 + wc * 32 + 8 * fq;
        LOAD_RS(rsv, rstd, row0)
#pragma unroll
        EPI_ROWS { const int row = row0 + ai * 128 + m * 16; const float rs = rsv[ai][m]; const size_t off = (size_t)row * DM + col;
#pragma unroll
            for (int bj = 0; bj < 2; ++bj) { const u32x4 ev = *(const u32x4*)(Eb + off + bj * 128); f32x4 o0, o1;
                const f32x4 a0 = acc[ai][bj][m][0] * rs, a1 = acc[ai][bj][m][1] * rs;
                o0[0] = sigmoidf_(a0[0]) * __uint_as_float(ev.x << 16); o0[1] = sigmoidf_(a0[1]) * __uint_as_float(ev.x & 0xffff0000u);
                o0[2] = sigmoidf_(a0[2]) * __uint_as_float(ev.y << 16); o0[3] = sigmoidf_(a0[3]) * __uint_as_float(ev.y & 0xffff0000u);
                o1[0] = sigmoidf_(a1[0]) * __uint_as_float(ev.z << 16); o1[1] = sigmoidf_(a1[1]) * __uint_as_float(ev.z & 0xffff0000u);
                o1[2] = sigmoidf_(a1[2]) * __uint_as_float(ev.w << 16); o1[3] = sigmoidf_(a1[3]) * __uint_as_float(ev.w & 0xffff0000u);
                st8(O + off + bj * 128, o0, o1); } }
    }
};
struct EpiWin {
    static constexpr bool PERM = true, AFTER_DRAIN = false;
    unsigned char* wsb;
    __device__ __forceinline__ void operator()(const f32x4 (&acc)[2][2][4][2], const Unit& u, int wr, int wc, int fr, int fq) const {
        asm volatile("" : "+v"(fr), "+v"(fq));
        const int pn = u.pn, row0 = u.pm * 256 + wr * 64 + fr, cw = wc * 32 + 8 * fq;
        bf16_t* glu = (bf16_t*)(wsb + WS_GLU); bf16_t* kr = (bf16_t*)(wsb + WS_KR); float* ssq = (float*)(wsb + WS_SSQ);
        const float* rstd = (const float*)(wsb + WS_RSTD);
        LOAD_RS(rsv, rstd, row0)
        const float* ccos = (const float*)(wsb + WS_COS); const float* csin = (const float*)(wsb + WS_SIN);
        if (pn <= 2) {
            bf16_t* base = (bf16_t*)(wsb + (pn < 2 ? WS_CQ : WS_CKV)); const int ld = pn < 2 ? 512 : 256, cb = (pn == 1 ? 256 : 0) + cw;
#pragma unroll
            EPI_ROWS { const int row = row0 + ai * 128 + m * 16; const float rs = rsv[ai][m]; float ss = 0.f;
#pragma unroll
                for (int bj = 0; bj < 2; ++bj) { const f32x4 v0 = acc[ai][bj][m][0] * rs, v1 = acc[ai][bj][m][1] * rs; st8(base + (size_t)row * ld + cb + bj * 128, v0, v1); ss += dot4(v0) + dot4(v1); }
                ss += __shfl_xor(ss, 16); ss += __shfl_xor(ss, 32);
                if (fq == 0) ssq[(size_t)row * 12 + pn * 4 + wc] = ss; }
        } else if (pn <= 6) {
            const int col = (pn - 3) * 128 + cw;
#pragma unroll
            EPI_ROWS { const int row = row0 + ai * 128 + m * 16; const float rs = rsv[ai][m]; f32x4 o[2];
#pragma unroll
                for (int n = 0; n < 2; ++n) { const f32x4 a = acc[ai][0][m][n] * rs, g = acc[ai][1][m][n] * rs;
#pragma unroll
                    for (int e = 0; e < 4; ++e) o[n][e] = a[e] * sigmoidf_(g[e]); }
                st8(glu + (size_t)row * 512 + col, o[0], o[1]); }
        } else if (pn <= 12) {
            const int which = (pn - 7) >> 1; bf16_t* base = (bf16_t*)(wsb + WS_SBQ + (size_t)which * (WS_SBK - WS_SBQ)); const float sc = which == 0 ? SBSCALE : 1.0f;
            const int cb = ((pn - 7) & 1) * 256 + cw;
#pragma unroll
            EPI_ROWS { const int row = row0 + ai * 128 + m * 16; const float rs = rsv[ai][m] * sc;
#pragma unroll
                for (int bj = 0; bj < 2; ++bj) st8(base + (size_t)row * 512 + cb + bj * 128, acc[ai][bj][m][0] * rs, acc[ai][bj][m][1] * rs); }
        } else {
            if (wc == 0) {
#pragma unroll
                EPI_ROWS { const int row = row0 + ai * 128 + m * 16;
#pragma unroll
                    for (int n = 0; n < 2; ++n) { const int j0 = 8 * fq + 4 * n; const f32x4 c4 = *(const f32x4*)(ccos + (size_t)row * 32 + j0), s4 = *(const f32x4*)(csin + (size_t)row * 32 + j0);
                        const float rs = rsv[ai][m]; const f32x4 x1 = acc[ai][0][m][n] * rs, x2 = acc[ai][1][m][n] * rs;
                        st4(kr + (size_t)row * 64 + j0, x1 * c4 - x2 * s4); st4(kr + (size_t)row * 64 + 32 + j0, x1 * s4 + x2 * c4); } }
            }
        }
    }
};
struct EpiUq {
    static constexpr bool PERM = true, AFTER_DRAIN = false;
    bf16_t* Q; const float* ssq; const float* ccos; const float* csin;
    __device__ __forceinline__ void operator()(const f32x4 (&acc)[2][2][4][2], const Unit& u, int wr, int wc, int fr, int fq) const {
        asm volatile("" : "+v"(fr), "+v"(fq));
        const int pn = u.pn, row0 = u.pm * 256 + wr * 64 + fr, cw = wc * 32 + 8 * fq;
#pragma unroll
        for (int ai = 0; ai < 2; ++ai) {
        f32x4 pa[4], pb[4];
#pragma unroll
        for (int m = 0; m < 4; ++m) { const int row = row0 + ai * 128 + m * 16; pa[m] = *(const f32x4*)(ssq + (size_t)row * 12); pb[m] = *(const f32x4*)(ssq + (size_t)row * 12 + 4); }
#pragma unroll
        for (int m = 0; m < 4; ++m) { const int row = row0 + ai * 128 + m * 16;
            const f32x4 p0 = pa[m], p1 = pb[m];
            const float s = ((p0[0] + p0[1]) + (p0[2] + p0[3])) + ((p1[0] + p1[1]) + (p1[2] + p1[3]));
            const float rs = rsqrtf(s * (1.0f / 512.0f) + EPS) * QSCALE;
            if (pn < 4) {
#pragma unroll
                for (int bj = 0; bj < 2; ++bj) st8(Q + (size_t)row * 1536 + (2 * pn + bj) * 192 + cw, acc[ai][bj][m][0] * rs, acc[ai][bj][m][1] * rs);
            } else {
                bf16_t* qh = Q + (size_t)row * 1536 + (4 * (pn - 4) + wc) * 192 + 128;
#pragma unroll
                for (int n = 0; n < 2; ++n) { const int j0 = 8 * fq + 4 * n; const f32x4 c4 = *(const f32x4*)(ccos + (size_t)row * 32 + j0), s4 = *(const f32x4*)(csin + (size_t)row * 32 + j0);
                    const f32x4 x1 = acc[ai][0][m][n] * rs, x2 = acc[ai][1][m][n] * rs;
                    st4(qh + j0, x1 * c4 - x2 * s4); st4(qh + 32 + j0, x1 * s4 + x2 * c4); }
            }
        }
        }
    }
};
struct EpiUkv {
    static constexpr bool PERM = true, AFTER_DRAIN = false;
    bf16_t* Kn; bf16_t* V; const float* ssq;
    __device__ __forceinline__ void operator()(const f32x4 (&acc)[2][2][4][2], const Unit& u, int wr, int wc, int fr, int fq) const {
        asm volatile("" : "+v"(fr), "+v"(fq));
        const int row0 = u.pm * 256 + wr * 64 + fr, col = u.pn * 128 + wc * 32 + 8 * fq;
        f32x4 pa[2][4];
#pragma unroll
        EPI_ROWS { pa[ai][m] = *(const f32x4*)(ssq + (size_t)(row0 + ai * 128 + m * 16) * 12 + 8); }
#pragma unroll
        EPI_ROWS { const int row = row0 + ai * 128 + m * 16;
            const f32x4 p0 = pa[ai][m];
            const float rs = rsqrtf(((p0[0] + p0[1]) + (p0[2] + p0[3])) * (1.0f / 256.0f) + EPS);
            st8(Kn + (size_t)row * 1024 + col, acc[ai][0][m][0] * rs, acc[ai][0][m][1] * rs);
            st8(V + (size_t)row * 1024 + col, acc[ai][1][m][0] * rs, acc[ai][1][m][1] * rs); }
    }
};

namespace att {
constexpr int ST_KN = 0, ST_V = 16384, ST_KR = 32768, ST_BYTES = 40960;
__device__ __forceinline__ int offb(int row, int ch) { return 256 * row + 16 * (ch ^ (((row & 3) << 2) | ((row >> 2) & 3))); }
__device__ __forceinline__ int off64(int row, int ch) { return 128 * row + 16 * (ch ^ ((row >> 1) & 7)); }
__device__ __forceinline__ bf16x8 mk8(v4i16_t lo, v4i16_t hi) { return (bf16x8){lo[0], lo[1], lo[2], lo[3], hi[0], hi[1], hi[2], hi[3]}; }
__device__ __forceinline__ v4i16_t trrd(LAS unsigned char* p) { return __builtin_amdgcn_ds_read_tr16_b64_v4i16((LAS v4i16_t*)p); }
__device__ __forceinline__ bf16x8 pack8(float a0, float a1, float a2, float a3, float a4, float a5, float a6, float a7) {
    u32x4 w; w.x = cvt_pk_bf16(a0, a1); w.y = cvt_pk_bf16(a2, a3); w.z = cvt_pk_bf16(a4, a5); w.w = cvt_pk_bf16(a6, a7);
    return __builtin_bit_cast(bf16x8, w);
}
__device__ __forceinline__ void pair32(float v, float& lo, float& hi_) { const auto rr = __builtin_amdgcn_permlane32_swap(__float_as_uint(v), __float_as_uint(v), false, false); lo = __uint_as_float(rr[0]); hi_ = __uint_as_float(rr[1]); }
__device__ __forceinline__ float mulf(float a, float b) { float r; asm("v_mul_f32_e32 %0, %1, %2" : "=v"(r) : "v"(a), "v"(b)); return r; }
__device__ __forceinline__ void sb_block(f32x16& S, float& running, int hi) {
#pragma unroll
    for (int gq = 3; gq >= 0; --gq) {
        float bt[4], kp[4];
#pragma unroll
        for (int e = 0; e < 4; ++e) { const float ee = fexp2(-S[4 * gq + e]); bt[e] = frcp(1.0f + ee); asm("v_sub_f32_e32 %0, 1.0, %1" : "=v"(kp[e]) : "v"(bt[e])); }
        const float own = mulf(mulf(kp[0], kp[1]), mulf(kp[2], kp[3])); float plo, phi; pair32(own, plo, phi);
        float E = mulf(running, hi ? 1.0f : phi);
        S[4 * gq + 3] = mulf(bt[3], E); E = mulf(E, kp[3]);
        S[4 * gq + 2] = mulf(bt[2], E); E = mulf(E, kp[2]);
        S[4 * gq + 1] = mulf(bt[1], E); E = mulf(E, kp[1]);
        S[4 * gq + 0] = mulf(bt[0], E);
        running = mulf(running, mulf(plo, phi));
    }
}

template <bool SB>
__device__ __forceinline__ void attn_unit(LAS unsigned char* lds, const bf16_t* __restrict__ Q, int qp, const bf16_t* __restrict__ K, int kp,
                                          const bf16_t* __restrict__ V, int vp, const bf16_t* __restrict__ KR, bf16_t* O, int tokbase, int qblk) {
    constexpr int NDN = 8, NDR = SB ? 0 : 4, ND = NDN + NDR;
    const int tid = otid(), lane = tid & 63, wid = __builtin_amdgcn_readfirstlane(tid >> 6), r32 = lane & 31, hi = lane >> 5;
    const bool lead = wid < 4;
    const int qw0 = qblk * 256 + wid * 32, tq = qw0 + r32;
    bf16x8 qf[ND];
    { const bf16_t* qrow = Q + (size_t)(tokbase + tq) * qp + 8 * hi;
#pragma unroll
      for (int ds = 0; ds < ND; ++ds) qf[ds] = *(const bf16x8*)(qrow + 16 * ds); }
    f32x16 o[4];
#pragma unroll
    for (int d0 = 0; d0 < 4; ++d0)
#pragma unroll
        for (int r = 0; r < 16; ++r) o[d0][r] = 0.f;
    float m_run = -1e30f, l_run = 0.f, running = 1.0f;
    const int NT = (qblk + 1) * 4;
    const bf16_t* gK; const bf16_t* gV; const bf16_t* gR = nullptr;
    { const int row = 4 * wid + (lane >> 4), ch = (lane & 15) ^ (((row & 3) << 2) | ((row >> 2) & 3));
      gK = K + (size_t)(tokbase + row) * kp + ch * 8; gV = V + (size_t)(tokbase + row) * vp + ch * 8;
      if (!SB) { const int rr = 8 * wid + (lane >> 3), cr = (lane & 7) ^ ((rr >> 1) & 7); gR = KR + (size_t)(tokbase + rr) * 64 + cr * 8; } }
    const unsigned pcs = (unsigned)wid * 1024u;
#define ATT_DMA(T, stw) do { const size_t ko = (size_t)(T) * 64 * kp, vo = (size_t)(T) * 64 * vp; \
        __builtin_amdgcn_global_load_lds((const unsigned*)(gK + ko), (LAS unsigned*)((stw) + ST_KN + pcs), 16, 0, 0); \
        __builtin_amdgcn_global_load_lds((const unsigned*)(gK + ko + (size_t)32 * kp), (LAS unsigned*)((stw) + ST_KN + 8192 + pcs), 16, 0, 0); \
        __builtin_amdgcn_global_load_lds((const unsigned*)(gV + vo), (LAS unsigned*)((stw) + ST_V + pcs), 16, 0, 0); \
        __builtin_amdgcn_global_load_lds((const unsigned*)(gV + vo + (size_t)32 * vp), (LAS unsigned*)((stw) + ST_V + 8192 + pcs), 16, 0, 0); \
        if (!SB) __builtin_amdgcn_global_load_lds((const unsigned*)(gR + (size_t)(T) * 64 * 64), (LAS unsigned*)((stw) + ST_KR + pcs), 16, 0, 0); } while (0)
#define ATT_BAR(more) do { if (more) { if (SB) asm volatile("s_waitcnt vmcnt(4) lgkmcnt(0)" ::: "memory"); else asm volatile("s_waitcnt vmcnt(5) lgkmcnt(0)" ::: "memory"); } \
        else asm volatile("s_waitcnt vmcnt(0) lgkmcnt(0)" ::: "memory"); __builtin_amdgcn_s_barrier(); asm volatile("" ::: "memory"); } while (0)
#define ATT_SB() __builtin_amdgcn_sched_barrier(0)
#define ATT_TILE(t_) (SB ? NT - 1 - (t_) : (t_))
    const int xk = ((r32 & 3) << 2) | ((r32 >> 2) & 3);
    const int krow = 256 * r32, rrw = 128 * r32, xr = (r32 >> 1) & 7;
    const int g4 = lane >> 4, tq4 = (lane & 15) >> 2, tp = lane & 3;
    f32x16 s0, s1;
#define ATT_KFRAG(dst, i, ds, stq) do { if ((ds) < NDN) { const int co = 16 * ((2 * (ds) + hi) ^ xk); \
            dst[2 * (i)] = *(const LAS bf16x8*)((stq) + ST_KN + krow + co); dst[2 * (i) + 1] = *(const LAS bf16x8*)((stq) + ST_KN + 8192 + krow + co); } \
        else { const int co = 16 * ((2 * ((ds) - NDN) + hi) ^ xr); \
            dst[2 * (i)] = *(const LAS bf16x8*)((stq) + ST_KR + rrw + co); dst[2 * (i) + 1] = *(const LAS bf16x8*)((stq) + ST_KR + 4096 + rrw + co); } } while (0)
#define ATT_QK(stq) do { \
        _Pragma("unroll") for (int r = 0; r < 16; ++r) { s0[r] = 0.f; s1[r] = 0.f; } \
        bf16x8 fa[4], fb[4]; \
        ATT_KFRAG(fa, 0, 0, stq); ATT_KFRAG(fa, 1, 1, stq); ATT_SB(); \
        _Pragma("unroll") for (int b = 0; b < ND / 2; b += 2) { \
            if (b + 1 < ND / 2) { ATT_KFRAG(fb, 0, 2 * b + 2, stq); ATT_KFRAG(fb, 1, 2 * b + 3, stq); } ATT_SB(); \
            s0 = __builtin_amdgcn_mfma_f32_32x32x16_bf16(fa[0], qf[2 * b], s0, 0, 0, 0); s1 = __builtin_amdgcn_mfma_f32_32x32x16_bf16(fa[1], qf[2 * b], s1, 0, 0, 0); \
            s0 = __builtin_amdgcn_mfma_f32_32x32x16_bf16(fa[2], qf[2 * b + 1], s0, 0, 0, 0); s1 = __builtin_amdgcn_mfma_f32_32x32x16_bf16(fa[3], qf[2 * b + 1], s1, 0, 0, 0); ATT_SB(); \
            if (b + 1 < ND / 2) { \
                if (b + 2 < ND / 2) { ATT_KFRAG(fa, 0, 2 * b + 4, stq); ATT_KFRAG(fa, 1, 2 * b + 5, stq); } ATT_SB(); \
                s0 = __builtin_amdgcn_mfma_f32_32x32x16_bf16(fb[0], qf[2 * b + 2], s0, 0, 0, 0); s1 = __builtin_amdgcn_mfma_f32_32x32x16_bf16(fb[1], qf[2 * b + 2], s1, 0, 0, 0); \
                s0 = __builtin_amdgcn_mfma_f32_32x32x16_bf16(fb[2], qf[2 * b + 3], s0, 0, 0, 0); s1 = __builtin_amdgcn_mfma_f32_32x32x16_bf16(fb[3], qf[2 * b + 3], s1, 0, 0, 0); ATT_SB(); } } \
    } while (0)
#define ATT_VFRAG(dst, ks, stv) do { \
        _Pragma("unroll") for (int d0 = 0; d0 < 4; ++d0) { \
            const int c = 4 * d0 + 2 * (g4 & 1) + (tp >> 1); \
            const int rowa = 4 * (g4 >> 1) + tq4, rowb = rowa + 8; \
            const int a0 = 256 * rowa + 16 * (c ^ (((rowa & 3) << 2) | ((rowa >> 2) & 3))) + 8 * (tp & 1); \
            const int a1 = 256 * rowb + 16 * (c ^ (((rowb & 3) << 2) | ((rowb >> 2) & 3))) + 8 * (tp & 1); \
            dst[d0] = mk8(trrd((stv) + ST_V + a0 + (ks) * 4096), trrd((stv) + ST_V + a1 + (ks) * 4096)); } } while (0)
#define ATT_SMPV(k0v, stv) do { \
        const int k0_ = (k0v); \
        bf16x8 va[4], vb[4]; \
        ATT_VFRAG(va, 0, stv); ATT_SB(); \
        if (k0_ + 63 >= qw0) { asm volatile("; tile on the causal diagonal: mask" ::: "memory");     \
            _Pragma("unroll") for (int r = 0; r < 16; ++r) { const int kv = k0_ + (r & 3) + 8 * (r >> 2) + 4 * hi + (SB ? 1 : 0); if (kv > tq) s0[r] = -1e30f; if (kv + 32 > tq) s1[r] = -1e30f; } } \
        if (SB) { sb_block(s1, running, hi); sb_block(s0, running, hi); } \
        else { \
            asm volatile("s_nop 15\n\ts_nop 7" : "+v"(s0), "+v"(s1));     \
            float mx; asm("v_max_f32_e32 %0, %1, %2" : "=v"(mx) : "v"(s0[0]), "v"(s1[0])); \
            _Pragma("unroll") for (int r = 1; r < 16; ++r) asm("v_max3_f32 %0, %1, %2, %3" : "=v"(mx) : "v"(mx), "v"(s0[r]), "v"(s1[r]));     \
            { float mlo, mhi; pair32(mx, mlo, mhi); mx = fmaxf(mlo, mhi); } \
            const bool grew = mx > m_run + 4.0f;     \
            const float mn = grew ? mx : m_run, alpha = fexp2(m_run - mn); \
            m_run = mn; \
            float ls = 0.f; \
            _Pragma("unroll") for (int r = 0; r < 16; ++r) { s0[r] = fexp2(s0[r] - mn); s1[r] = fexp2(s1[r] - mn); ls += s0[r] + s1[r]; } \
            l_run = l_run * alpha + ls; \
            if (__any(grew)) { _Pragma("unroll") for (int d0 = 0; d0 < 4; ++d0) _Pragma("unroll") for (int r = 0; r < 16; ++r) o[d0][r] *= alpha; } \
        } \
        bf16x8 pf[4]; \
        pf[0] = pack8(s0[0], s0[1], s0[2], s0[3], s0[4], s0[5], s0[6], s0[7]); \
        pf[1] = pack8(s0[8], s0[9], s0[10], s0[11], s0[12], s0[13], s0[14], s0[15]); \
        pf[2] = pack8(s1[0], s1[1], s1[2], s1[3], s1[4], s1[5], s1[6], s1[7]); \
        pf[3] = pack8(s1[8], s1[9], s1[10], s1[11], s1[12], s1[13], s1[14], s1[15]); \
        ATT_SB(); ATT_VFRAG(vb, 1, stv); ATT_SB(); \
        _Pragma("unroll") for (int d0 = 0; d0 < 4; ++d0) o[d0] = __builtin_amdgcn_mfma_f32_32x32x16_bf16(va[d0], pf[0], o[d0], 0, 0, 0); \
        ATT_SB(); ATT_VFRAG(va, 2, stv); ATT_SB(); \
        _Pragma("unroll") for (int d0 = 0; d0 < 4; ++d0) o[d0] = __builtin_amdgcn_mfma_f32_32x32x16_bf16(vb[d0], pf[1], o[d0], 0, 0, 0); \
        ATT_SB(); ATT_VFRAG(vb, 3, stv); ATT_SB(); \
        _Pragma("unroll") for (int d0 = 0; d0 < 4; ++d0) o[d0] = __builtin_amdgcn_mfma_f32_32x32x16_bf16(va[d0], pf[2], o[d0], 0, 0, 0); \
        ATT_SB(); \
        _Pragma("unroll") for (int d0 = 0; d0 < 4; ++d0) o[d0] = __builtin_amdgcn_mfma_f32_32x32x16_bf16(vb[d0], pf[3], o[d0], 0, 0, 0); \
    } while (0)
    ATT_DMA(ATT_TILE(0), lds);
    ATT_DMA(ATT_TILE(1), lds + ST_BYTES);
    ATT_BAR(true);
    if (!lead) ATT_BAR(true);
    int cur = 0;
    for (int t = 0; t < NT; ++t) {
        LAS unsigned char* stc = lds + cur * ST_BYTES;
        LAS unsigned char* stn = lds + (cur == 0 ? 2 : cur - 1) * ST_BYTES;
        const int k0 = ATT_TILE(t) * 64;
        const bool act = (k0 <= qw0 + 31);
        const bool more = t + 2 < NT;
        if (!lead && more) ATT_DMA(ATT_TILE(t + 2), stn);
        if (act) { ATT_QK(stc); }
        ATT_BAR(lead ? (t + 1 < NT) : more);
        if (lead && more) ATT_DMA(ATT_TILE(t + 2), stn);
        if (act) { ATT_SMPV(k0, stc); }
        ATT_BAR(more);
        cur = (cur == 2) ? 0 : cur + 1;
    }
    if (lead) ATT_BAR(false);
#undef ATT_DMA
#undef ATT_BAR
#undef ATT_SB
#undef ATT_TILE
#undef ATT_KFRAG
#undef ATT_QK
#undef ATT_VFRAG
#undef ATT_SMPV
    float inv = 1.0f;
    if (!SB) { float llo, lhi; pair32(l_run, llo, lhi); inv = 1.0f / (llo + lhi); }
    bf16_t* orow = O + (size_t)(tokbase + tq) * DM + 4 * hi;
#pragma unroll
    for (int d0 = 0; d0 < 4; ++d0)
#pragma unroll
        for (int gq = 0; gq < 4; ++gq) {
            f32x4 v; v[0] = o[d0][4 * gq] * inv; v[1] = o[d0][4 * gq + 1] * inv; v[2] = o[d0][4 * gq + 2] * inv; v[3] = o[d0][4 * gq + 3] * inv;
            st4(orow + 32 * d0 + 8 * gq, v);
        }
}
}

__device__ __forceinline__ int srccol(int mode, int nb) {
    if (mode == 0) return 32 * nb;
    if (mode == 1) { const int pn = nb >> 3, q = nb & 7; return (q >> 2) * DFF + 128 * pn + 32 * (q & 3); }
    if (mode == 2) {
        if (nb < 16) return 32 * nb;
        if (nb < 24) return 512 + 32 * (nb - 16);
        if (nb < 56) { const int t = (nb - 24) >> 3, q = (nb - 24) & 7; return 832 + (q >> 2) * 512 + 128 * t + 32 * (q & 3); }
        if (nb < 104) return 1856 + 32 * (nb - 56);
        if (nb == 104) return 768;
        if (nb == 108) return 800;
        return -1;
    }
    if (nb < 32) return 192 * (nb >> 2) + 32 * (nb & 3);
    { const int t = (nb - 32) >> 3, q = (nb - 32) & 7; return 192 * (4 * t + (q & 3)) + 128 + 32 * (q >> 2); }
}
__device__ __forceinline__ unsigned f2bf(float f) { unsigned u = __builtin_bit_cast(unsigned, f); return (u + 0x7fffu + ((u >> 16) & 1u)) >> 16; }
__device__ __forceinline__ unsigned pk2(float lo, float hi) { return f2bf(lo) | (f2bf(hi) << 16); }
__device__ __forceinline__ void tr_item(const float* __restrict__ W, int K, int N, const float* __restrict__ gain, bf16_t* WT, int nblk2  , int mode, LAS bf16_t* scr, int item, int lane) {
    const int kb = item / nblk2, nb2 = item - kb * nblk2, k0 = 64 * kb;
    const int blk = (lane >> 3) & 1, n4 = (lane & 7) * 4, kr0 = lane >> 4;
    const int sc = srccol(mode, 2 * nb2 + blk);
    f32x4 v[16];
    const float* src = W + (size_t)(k0 + kr0) * N + (sc >= 0 ? sc : 0) + n4;
#pragma unroll
    for (int i = 0; i < 16; ++i) v[i] = *(const f32x4*)(src + (size_t)(4 * i) * N);
    if (gain) {
#pragma unroll
        for (int i = 0; i < 16; ++i) v[i] = v[i] * gain[k0 + kr0 + 4 * i];
    }
    if (sc < 0) {
#pragma unroll
        for (int i = 0; i < 16; ++i) v[i] = (f32x4){0.f, 0.f, 0.f, 0.f};
    }
    LAS bf16_t* d = scr + (32 * blk + n4) * 66 + kr0;
#pragma unroll
    for (int i = 0; i < 16; ++i) {
        const unsigned p01 = cvt_pk_bf16(v[i][0], v[i][1]), p23 = cvt_pk_bf16(v[i][2], v[i][3]);
        d[0 * 66 + 4 * i] = (bf16_t)(p01 & 0xffffu); d[1 * 66 + 4 * i] = (bf16_t)(p01 >> 16);
        d[2 * 66 + 4 * i] = (bf16_t)(p23 & 0xffffu); d[3 * 66 + 4 * i] = (bf16_t)(p23 >> 16);
    }
    asm volatile("s_waitcnt lgkmcnt(0)" ::: "memory");
    const int c = lane & 7;
#pragma unroll
    for (int j = 0; j < 8; ++j) { const int n = (lane >> 3) + 8 * j; const LAS unsigned* sp = (const LAS unsigned*)(scr + n * 66 + 8 * c);
        u32x4 o; o.x = sp[0]; o.y = sp[1]; o.z = sp[2]; o.w = sp[3];
        *(u32x4*)(WT + (size_t)(64 * nb2 + n) * K + k0 + 8 * c) = o; }
    asm volatile("s_waitcnt lgkmcnt(0)" ::: "memory");
}
template <int MODE>
__device__ __forceinline__ void row_phase(const float* x32, bf16_t* xb, const bf16_t* f, const float* g, float c, float* rstd, float* out32) {
    const int tid = otid(), lane = tid & 63, gw = blockIdx.x * 8 + __builtin_amdgcn_readfirstlane(tid >> 6), ngw = gridDim.x * 8;
    for (int m = gw; m < M_TOK; m += ngw) {
        float xv[4][8];
        const size_t ro = (size_t)m * DM + 8 * lane;
        if (MODE == 0) {
#pragma unroll
            for (int j = 0; j < 4; ++j) { const f32x4 a = *(const f32x4*)(x32 + ro + 512 * j), b = *(const f32x4*)(x32 + ro + 512 * j + 4);
#pragma unroll
                for (int e = 0; e < 4; ++e) { xv[j][e] = a[e]; xv[j][4 + e] = b[e]; } }
        } else {
            u32x4 xr[4], fr_[4];
#pragma unroll
            for (int j = 0; j < 4; ++j) { xr[j] = *(const u32x4*)(xb + ro + 512 * j); fr_[j] = *(const u32x4*)(f + ro + 512 * j); }
            float fv[4][8]; float s = 0.f;
#pragma unroll
            for (int j = 0; j < 4; ++j)
#pragma unroll
                for (int q = 0; q < 4; ++q) { const unsigned fu = fr_[j][q], xu = xr[j][q];
                    fv[j][2 * q] = __uint_as_float(fu << 16); fv[j][2 * q + 1] = __uint_as_float(fu & 0xffff0000u);
                    xv[j][2 * q] = __uint_as_float(xu << 16); xv[j][2 * q + 1] = __uint_as_float(xu & 0xffff0000u);
                    s += fv[j][2 * q] * fv[j][2 * q] + fv[j][2 * q + 1] * fv[j][2 * q + 1]; }
            s = wave_sum(s); const float rs = rsqrtf(s * (1.0f / DM) + EPS) * c;
#pragma unroll
            for (int j = 0; j < 4; ++j) { const f32x4 g0 = *(const f32x4*)(g + 8 * lane + 512 * j), g1 = *(const f32x4*)(g + 8 * lane + 512 * j + 4);
#pragma unroll
                for (int e = 0; e < 4; ++e) { xv[j][e] += fv[j][e] * g0[e] * rs; xv[j][4 + e] += fv[j][4 + e] * g1[e] * rs; } }
        }
        if (MODE == 2) {
#pragma unroll
            for (int j = 0; j < 4; ++j) { *(f32x4*)(out32 + ro + 512 * j) = (f32x4){xv[j][0], xv[j][1], xv[j][2], xv[j][3]}; *(f32x4*)(out32 + ro + 512 * j + 4) = (f32x4){xv[j][4], xv[j][5], xv[j][6], xv[j][7]}; }
        } else {
            float s2 = 0.f;
#pragma unroll
            for (int j = 0; j < 4; ++j)
#pragma unroll
                for (int e = 0; e < 8; ++e) s2 += xv[j][e] * xv[j][e];
            s2 = wave_sum(s2);
            if (lane == 0) rstd[m] = rsqrtf(s2 * (1.0f / DM) + EPS);
#pragma unroll
            for (int j = 0; j < 4; ++j) { u32x4 w; w.x = cvt_pk_bf16(xv[j][0], xv[j][1]); w.y = cvt_pk_bf16(xv[j][2], xv[j][3]); w.z = cvt_pk_bf16(xv[j][4], xv[j][5]); w.w = cvt_pk_bf16(xv[j][6], xv[j][7]);
                *(u32x4*)(xb + ro + 512 * j) = w; }
        }
    }
}
__device__ __forceinline__ float bf2f(bf16_t v) { return __uint_as_float((unsigned)v << 16); }
__device__ __forceinline__ void conv_phase(LAS unsigned char* lds, const bf16_t* glu, const float* wdw, const float* bdw, const float* gln, const float* bln, bf16_t* cv, int blk, int nblk) {
    const int tid = otid();
    LAS bf16_t* gs = (LAS bf16_t*)lds;
    LAS float* ys = (LAS float*)(lds + 64 * 1024);
    LAS float* stat = (LAS float*)(lds + 48 * 1024 + 1024);
    const int c = tid;
    float w[31];
#pragma unroll
    for (int i = 0; i < 31; ++i) w[i] = wdw[i * 512 + c];
    const float bd = bdw[c], gl = gln[c], bl = bln[c];
    const bool bal = (nblk == 256); const int nu = bal ? (blk < 128 ? 3 : 5) : (M_TOK / 16 - blk + nblk - 1) / nblk;
    for (int ui = 0; ui < nu; ++ui) {
        const int unit = bal ? (blk < 128 ? blk + 128 * ui : 384 + (blk - 128) + 128 * ui) : blk + ui * nblk;
        const int tok0 = unit * 16, t0 = tok0 & (SEQ - 1);
        for (int idx = tid; idx < 46 * 64; idx += 512) { const int row = idx >> 6, ch = idx & 63; u32x4 v = (u32x4){0u, 0u, 0u, 0u};
            if (t0 - 30 + row >= 0) v = *(const u32x4*)(glu + (size_t)(tok0 - 30 + row) * 512 + ch * 8);
            *(LAS u32x4*)(gs + row * 512 + ch * 8) = v; }
        __syncthreads();
        float y[16];
#pragma unroll
        for (int t = 0; t < 16; ++t) y[t] = bd;
#pragma unroll
        for (int rr = 0; rr < 46; ++rr) { const float gval = bf2f(gs[rr * 512 + c]);
#pragma unroll
            for (int t = 0; t < 16; ++t) { if (rr - t >= 0 && rr - t <= 30) y[t] += gval * w[rr - t]; } }
#pragma unroll
        for (int t = 0; t < 16; ++t) ys[t * 512 + c] = y[t];
        __syncthreads();
        { const int t2 = tid >> 5, p = tid & 31; float sm = 0.f, sq = 0.f;
#pragma unroll
          for (int i = 0; i < 16; ++i) { const float v = ys[t2 * 512 + p + 32 * i]; sm += v; sq += v * v; }
#pragma unroll
          for (int o = 1; o < 32; o <<= 1) { sm += __shfl_xor(sm, o); sq += __shfl_xor(sq, o); }
          if (p == 0) { const float mean = sm * (1.0f / 512.0f), var = fmaxf(sq * (1.0f / 512.0f) - mean * mean, 0.f); stat[t2 * 2] = mean; stat[t2 * 2 + 1] = rsqrtf(var + EPS); } }
        __syncthreads();
#pragma unroll
        for (int t = 0; t < 16; ++t) { const float v = (y[t] - stat[t * 2]) * stat[t * 2 + 1] * gl + bl; cv[(size_t)(tok0 + t) * 512 + c] = (bf16_t)f2bf(v * sigmoidf_(v)); }
        __syncthreads();
    }
}

#define XB_TMO      128
#define XB_XCNT(j)  (256  + 64 * (j))
#define XB_XSUB(j)  (1280 + 64 * (j))
#define XB_XGEN(j)  (2304 + 64 * (j))
#define XB_TOP      3328
#define XB_TOPGEN   3392
#define XCD_BAR_WORDS 3456
#define XB_SPIN_CAP (1u << 18)

__device__ __forceinline__ unsigned xb_ld(unsigned* p)              { return __hip_atomic_load(p, __ATOMIC_RELAXED, __HIP_MEMORY_SCOPE_AGENT); }
__device__ __forceinline__ unsigned xb_add(unsigned* p, unsigned v) { return __hip_atomic_fetch_add(p, v, __ATOMIC_RELAXED, __HIP_MEMORY_SCOPE_AGENT); }
__device__ __forceinline__ unsigned xb_xcc_id() { return (unsigned)__builtin_amdgcn_s_getreg((3 << 11) | 20) & 0xFu; }
#define XB_SPIN(cond, bar) do { unsigned _sp = 0; while (cond) { __builtin_amdgcn_s_sleep(1); \
    if ((++_sp & 255u) == 0u) { if (xb_ld(&(bar)[XB_TMO])) break; if (_sp > XB_SPIN_CAP) { atomicAdd(&(bar)[XB_TMO], 1u); break; } } } } while (0)

struct XcdBarrier {
    unsigned* bar; unsigned x;
    volatile LAS unsigned* st;
};

__device__ __forceinline__ XcdBarrier xcd_barrier_post(unsigned* bar, volatile LAS unsigned* st) {
    XcdBarrier b; b.bar = bar; b.x = xb_xcc_id(); b.st = st;
    if (threadIdx.x == 0) (void)xb_add(&bar[XB_XCNT(b.x)], 1u);
    return b;
}
__device__ __forceinline__ void xcd_barrier_complete(unsigned* bar, unsigned x, unsigned& nloc, unsigned& nx) {
    const unsigned G = gridDim.x * gridDim.y * gridDim.z;
    unsigned sum, cnt, mine, sp = 0u;
    for (;;) {
        sum = 0u; cnt = 0u; mine = 0u;
#pragma unroll
        for (unsigned j = 0; j < 16; ++j) { const unsigned c = xb_ld(&bar[XB_XCNT(j)]); sum += c; cnt += (c > 0u) ? 1u : 0u; mine = (j == x) ? c : mine; }
        if (sum == G) break;
        __builtin_amdgcn_s_sleep(1);
        if ((++sp & 255u) == 0u) { if (xb_ld(&bar[XB_TMO])) break; if (sp > XB_SPIN_CAP) { atomicAdd(&bar[XB_TMO], 1u); break; } }
    }
    nloc = mine > 0u ? mine : 1u; nx = cnt > 0u ? cnt : 1u;
}

__device__ __forceinline__ void xcd_barrier(const XcdBarrier& b) {
    asm volatile("s_waitcnt vmcnt(0)" ::: "memory");
    __syncthreads();
    if (threadIdx.x == 0) {
        unsigned* bar = b.bar;
        __builtin_amdgcn_s_waitcnt(0);
        unsigned nloc = b.st[0], nx = b.st[1];
        if (nloc == 0u) { xcd_barrier_complete(bar, b.x, nloc, nx); b.st[0] = nloc; b.st[1] = nx; }
        const unsigned old = xb_add(&bar[XB_XSUB(b.x)], 1u);
        const unsigned gen = old / nloc;
        if (old + 1u == (gen + 1u) * nloc) {
            __builtin_amdgcn_fence(__ATOMIC_RELEASE, "agent");
            asm volatile("s_waitcnt vmcnt(0)" ::: "memory");
            const unsigned og = xb_add(&bar[XB_TOP], 1u);
            const unsigned tg = og / nx;
            if (og + 1u == (tg + 1u) * nx) xb_add(&bar[XB_TOPGEN], 1u);
            else XB_SPIN(xb_ld(&bar[XB_TOPGEN]) == tg, bar);
            __builtin_amdgcn_fence(__ATOMIC_ACQUIRE, "agent");
            xb_add(&bar[XB_XGEN(b.x)], 1u);
            asm volatile("s_waitcnt vmcnt(0)" ::: "memory");
        } else {
            XB_SPIN(xb_ld(&bar[XB_XGEN(b.x)]) == gen, bar);
            __builtin_amdgcn_fence(__ATOMIC_ACQUIRE, "agent");
            asm volatile("s_waitcnt vmcnt(0)" ::: "memory");
        }
    }
    __syncthreads();
}

#ifndef PHMASK
#define PHMASK 0xffff
#endif
#define PH_ON(k) (((PHMASK) >> (k)) & 1)
#ifndef REP_P0
#define REP_P0 1
#endif
#ifndef REP_FFN
#define REP_FFN 1
#endif
#ifndef REP_ATT
#define REP_ATT 1
#endif
#ifndef REP_ROW
#define REP_ROW 1
#endif
struct Params { const float* in[28]; float* out; unsigned char* ws; };
static_assert(sizeof(Params) == 30 * 8, "no padding");
typedef pg8::StaticOrder SO;
#define GEMM_RUN(EPI_T, epi, Aptr, Bptr, Nn, Kk) GEMM_RUN_G(EPI_T, epi, Aptr, Bptr, Nn, Kk, G, bx)
#define GEMM_RUN_G(EPI_T, epi, Aptr, Bptr, Nn, Kk, GG, CC) do { int kk_ = (Kk); asm volatile("" : "+s"(kk_));     \
        pg8::Gemm g_{(const bf16_t*)(Aptr), (const bf16_t*)(Bptr), M_TOK, (Nn), kk_}; SO S_; S_.init(M_TOK, (Nn), (GG), (CC)); \
        pg8::gemm_phase<EPI_T, SO, true, true>(lds, g_, S_, (epi)); } while (0)

__device__ __forceinline__ unsigned char* ows(unsigned char* p) { __attribute__((address_space(1))) unsigned char* g = (__attribute__((address_space(1))) unsigned char*)p; asm volatile("" : "+s"(g)); return (unsigned char*)g; }
#define BF(off) ((bf16_t*)(wsp + (off)))
#define FP(off) ((float*)(wsp + (off)))
__global__ void __launch_bounds__(512) mega_fwd(Params P) {
    extern __shared__ __attribute__((aligned(16))) unsigned char lds_raw[];
    LAS unsigned char* lds = (LAS unsigned char*)lds_raw;
    cg::grid_group grid = cg::this_grid();
    const int G = gridDim.x, bx = blockIdx.x;
    if (threadIdx.x < 64) ((LAS unsigned*)(lds + MISC_OFF))[threadIdx.x] = 0u;
    __syncthreads();
    const XcdBarrier bar = xcd_barrier_post((unsigned*)P.ws + CW_BAR, (volatile LAS unsigned*)(lds + MISC_OFF + 64));
    if (P.ws == nullptr) grid.sync();
#define SEAM() do { XcdBarrier b_ = bar; asm volatile("" : "+s"(b_.bar), "+s"(b_.x)); xcd_barrier(b_); } while (0)

    for (int rep0 = 0; rep0 < REP_P0; ++rep0) {
        unsigned char* wsp = ows(P.ws);
        const int tid = otid(), lane = tid & 63, wid = __builtin_amdgcn_readfirstlane(tid >> 6), gw = bx * 8 + wid, ngw = G * 8;
        LAS bf16_t* scr = (LAS bf16_t*)(lds + wid * 16384);
        constexpr int I1 = 5632, I2 = 2816, I3 = 1792, I4 = 192, I5 = 128, I6 = 64, I7 = 1024, I10 = 1024, I11 = 128;
        constexpr int IL = I1 + I2 + I3 + I4 + I5 + I6 + I7 + I1 + I2 + I10 + I11;
        for (int it = gw; it < 2 * IL; it += ngw) {
            const int L = it >= IL ? 1 : 0; int r = it - L * IL;
            unsigned char* wl = wsp + WS_W + (size_t)L * W_LAYER;
            if (r < I1) { tr_item(P.in[4] + (size_t)L * DM * 2 * DFF, DM, 2 * DFF, P.in[3] + L * DM, (bf16_t*)(wl + WO_FF1IN), 176, 1, scr, r, lane); continue; } r -= I1;
            if (r < I2) { tr_item(P.in[5] + (size_t)L * DFF * DM, DFF, DM, nullptr, (bf16_t*)(wl + WO_FF1OUT), 32, 0, scr, r, lane); continue; } r -= I2;
            if (r < I3) { tr_item(P.in[8] + (size_t)L * DM * 3392, DM, 3392, P.in[7] + L * DM, (bf16_t*)(wl + WO_IN), 56, 2, scr, r, lane); continue; } r -= I3;
            if (r < I4) { tr_item(P.in[10] + (size_t)L * 512 * 1536, 512, 1536, P.in[9] + L * 512, (bf16_t*)(wl + WO_UQ), 24, 3, scr, r, lane); continue; } r -= I4;
            if (r < I5) { tr_item(P.in[12] + (size_t)L * 256 * 2048, 256, 2048, P.in[11] + L * 256, (bf16_t*)(wl + WO_UKV), 32, 0, scr, r, lane); continue; } r -= I5;
            if (r < I6) { tr_item(P.in[17] + (size_t)L * 512 * 512, 512, 512, nullptr, (bf16_t*)(wl + WO_PW), 8, 0, scr, r, lane); continue; } r -= I6;
            if (r < I7) { tr_item(P.in[18] + (size_t)L * DM * DM, DM, DM, nullptr, (bf16_t*)(wl + WO_OUT), 32, 0, scr, r, lane); continue; } r -= I7;
            if (r < I1) { tr_item(P.in[21] + (size_t)L * DM * 2 * DFF, DM, 2 * DFF, P.in[20] + L * DM, (bf16_t*)(wl + WO_FF2IN), 176, 1, scr, r, lane); continue; } r -= I1;
            if (r < I2) { tr_item(P.in[22] + (size_t)L * DFF * DM, DFF, DM, nullptr, (bf16_t*)(wl + WO_FF2OUT), 32, 0, scr, r, lane); continue; } r -= I2;
            if (r < I10) { tr_item(P.in[25] + (size_t)L * DM * DM, DM, DM, P.in[24] + L * DM, (bf16_t*)(wl + WO_GATE), 32, 0, scr, r, lane); continue; } r -= I10;
            tr_item(P.in[26] + (size_t)L * 256 * DM, 256, DM, nullptr, (bf16_t*)(wl + WO_PROJ), 32, 0, scr, r, lane);
        }
        const int gt = bx * 512 + tid, ngt = G * 512;
        for (int i = gt; i < 2 * M_TOK * 256 / 4; i += ngt) { const f32x4 v = ((const f32x4*)P.in[1])[i]; u32x2 w; w.x = cvt_pk_bf16(v[0], v[1]); w.y = cvt_pk_bf16(v[2], v[3]); ((u32x2*)BF(WS_PB))[i] = w; }
        const int* pos = (const int*)P.in[2];
        for (int i = gt; i < M_TOK * 32; i += ngt) { const int tok = i >> 5, j = i & 31;
            const float inv = exp2f(-(float)j * (13.287712379549449f / 32.0f));
            const float ang = (float)pos[tok] * inv;
            double rev = (double)ang * 0.15915494309189535; rev -= floor(rev);
            FP(WS_COS)[i] = __builtin_amdgcn_cosf((float)rev); FP(WS_SIN)[i] = __builtin_amdgcn_sinf((float)rev); }
        row_phase<0>(P.in[0], BF(WS_XN), nullptr, nullptr, 0.f, FP(WS_RSTD), nullptr);
    }
    SEAM();

    for (int L = 0; L < 2; ++L) {
        for (int rf = 0; rf < REP_FFN; ++rf) { unsigned char* wsp = ows(P.ws); unsigned char* wl = wsp + WS_W + (size_t)L * W_LAYER; EpiSwiglu E{BF(WS_HID), FP(WS_RSTD)}; GEMM_RUN(EpiSwiglu, E, BF(WS_XN), wl + WO_FF1IN, 2 * DFF, DM); }
        SEAM();
        for (int rf = 0; rf < REP_FFN; ++rf) { unsigned char* wsp = ows(P.ws); unsigned char* wl = wsp + WS_W + (size_t)L * W_LAYER; EpiBf E{BF(WS_F), DM}; GEMM_RUN(EpiBf, E, BF(WS_HID), wl + WO_FF1OUT, DM, DFF); }
        SEAM();
        if (PH_ON(3)) { unsigned char* wsp = ows(P.ws); row_phase<1>(nullptr, BF(WS_XN), BF(WS_F), P.in[6] + L * DM, 0.5f, FP(WS_RSTD), nullptr); }
        SEAM();
        if (PH_ON(4)) { unsigned char* wsp = ows(P.ws); unsigned char* wl = wsp + WS_W + (size_t)L * W_LAYER; EpiWin E{wsp}; GEMM_RUN(EpiWin, E, BF(WS_XN), wl + WO_IN, NWIN, DM);
            if (PH_ON(11) && G == 256 && bx >= 128) { EpiBf E2{BF(WS_EB), DM}; GEMM_RUN_G(EpiBf, E2, BF(WS_PB) + (size_t)L * M_TOK * 256, wl + WO_PROJ, DM, 256, 128, bx - 128); } }
        SEAM();
        if (PH_ON(5)) { unsigned char* wsp = ows(P.ws); conv_phase(lds, BF(WS_GLU), P.in[13] + L * 31 * 512, P.in[14] + L * 512, P.in[15] + L * 512, P.in[16] + L * 512, BF(WS_CV), bx, G); }
        if (PH_ON(6)) { unsigned char* wsp = ows(P.ws); unsigned char* wl = wsp + WS_W + (size_t)L * W_LAYER; EpiUq E{BF(WS_Q), FP(WS_SSQ), FP(WS_COS), FP(WS_SIN)}; GEMM_RUN(EpiUq, E, BF(WS_CQ), wl + WO_UQ, 1536, 512); }
        if (PH_ON(7)) { unsigned char* wsp = ows(P.ws); unsigned char* wl = wsp + WS_W + (size_t)L * W_LAYER; EpiUkv E{BF(WS_KN), BF(WS_V), FP(WS_SSQ)}; GEMM_RUN(EpiUkv, E, BF(WS_CKV), wl + WO_UKV, 2048, 256); }
        SEAM();
        if (PH_ON(8)) { unsigned char* wsp = ows(P.ws); unsigned char* wl = wsp + WS_W + (size_t)L * W_LAYER; EpiBf E{BF(WS_MIX) + 1024, DM}; GEMM_RUN(EpiBf, E, BF(WS_CV), wl + WO_PW, 512, 512); }
        if (PH_ON(9) || PH_ON(10)) {
            unsigned char* wsp = ows(P.ws);
            LAS int* slot = (LAS int*)(lds + MISC_OFF);
            const int tid = otid();
            for (;;) {
                __syncthreads();
                const int nq = G == 256 ? 96 : 768;
                if (tid == 0) {
                    int xs = G == 256 ? (bx & 7) : 0, got = -1;
                    for (int k = 0; k < (G == 256 ? 8 : 1); ++k) {
                        const int i_ = (int)atomicAdd((unsigned*)wsp + 64 * (L * 8 + xs), 1u);
                        if (i_ < nq) { got = i_; break; }
                        xs = (xs + 1) & 7;
                    }
                    slot[0] = got; slot[1] = xs;
                }
                __syncthreads();
                const int it = __builtin_amdgcn_readfirstlane(slot[0]), xq = __builtin_amdgcn_readfirstlane(slot[1]);
                if (it < 0) break;
                int qblk, r; bool sb;
                if (G == 256) { const int lvl = it / 6; r = it - lvl * 6; qblk = 15 - lvl; sb = r < 2; r = sb ? 2 * xq + r : 4 * xq + (r - 2); }
                else { const int lvl = it / 48; r = it - lvl * 48; qblk = 15 - lvl; sb = r < 16; r = sb ? r : r - 16; }
                const bool prb = false;
                if (sb) { if (PH_ON(9)) { const int b = r >> 2, h = r & 3;
                    att::attn_unit<true>(lds, BF(WS_SBQ) + h * 128, 512, BF(WS_SBK) + h * 128, 512, BF(WS_SBV) + h * 128, 512, nullptr, BF(WS_MIX) + 1536 + h * 128, b * SEQ, qblk); }
                } else if (PH_ON(10)) { const int b = r >> 3, h = r & 7;
                    att::attn_unit<false>(lds, BF(WS_Q) + h * 192, 1536, BF(WS_KN) + h * 128, 1024, BF(WS_V) + h * 128, 1024, BF(WS_KR), BF(WS_MIX) + h * 128, b * SEQ, qblk); }
            }
        }
        SEAM();
        if (PH_ON(2)) { unsigned char* wsp = ows(P.ws); unsigned char* wl = wsp + WS_W + (size_t)L * W_LAYER; EpiBf E{BF(WS_F), DM}; GEMM_RUN(EpiBf, E, BF(WS_MIX), wl + WO_OUT, DM, DM); }
        SEAM();
        if (PH_ON(3)) { unsigned char* wsp = ows(P.ws); row_phase<1>(nullptr, BF(WS_XN), BF(WS_F), P.in[19] + L * DM, 1.0f, FP(WS_RSTD), nullptr); }
        SEAM();
        for (int rf = 0; rf < REP_FFN; ++rf) { unsigned char* wsp = ows(P.ws); unsigned char* wl = wsp + WS_W + (size_t)L * W_LAYER; EpiSwiglu E{BF(WS_HID), FP(WS_RSTD)}; GEMM_RUN(EpiSwiglu, E, BF(WS_XN), wl + WO_FF2IN, 2 * DFF, DM); }
        SEAM();
        for (int rf = 0; rf < REP_FFN; ++rf) { unsigned char* wsp = ows(P.ws); unsigned char* wl = wsp + WS_W + (size_t)L * W_LAYER; EpiBf E{BF(WS_F), DM}; GEMM_RUN(EpiBf, E, BF(WS_HID), wl + WO_FF2OUT, DM, DFF); }
        SEAM();
        if (PH_ON(3)) { unsigned char* wsp = ows(P.ws); row_phase<1>(nullptr, BF(WS_XN), BF(WS_F), P.in[23] + L * DM, 0.5f, FP(WS_RSTD), nullptr); }
        SEAM();
        if (PH_ON(11) && G != 256) { unsigned char* wsp = ows(P.ws); unsigned char* wl = wsp + WS_W + (size_t)L * W_LAYER; EpiBf E{BF(WS_EB), DM}; GEMM_RUN(EpiBf, E, BF(WS_PB) + (size_t)L * M_TOK * 256, wl + WO_PROJ, DM, 256); SEAM(); }
        if (PH_ON(12)) { unsigned char* wsp = ows(P.ws); unsigned char* wl = wsp + WS_W + (size_t)L * W_LAYER; EpiGate E{BF(WS_F), BF(WS_EB), FP(WS_RSTD)}; GEMM_RUN(EpiGate, E, BF(WS_XN), wl + WO_GATE, DM, DM); }
        SEAM();
        if (PH_ON(3)) { unsigned char* wsp = ows(P.ws);
            if (L == 0) row_phase<1>(nullptr, BF(WS_XN), BF(WS_F), P.in[27] + L * DM, 1.0f, FP(WS_RSTD), nullptr);
            else row_phase<2>(nullptr, BF(WS_XN), BF(WS_F), P.in[27] + L * DM, 1.0f, nullptr, P.out); }
        if (L == 0) SEAM();
    }
}

extern "C" void kernel_launch(void* const* d_in, const int* in_sizes, int n_in, void* d_out, int out_size, void* d_ws, size_t ws_size, hipStream_t stream) {
    static int grid = 0;
    if (grid == 0) {
        if (n_in != 28 || out_size != M_TOK * DM || ws_size < WS_END) { fprintf(stderr, "kernel_launch: unexpected shapes (n_in %d out %d ws %zu)\n", n_in, out_size, ws_size); grid = -1; return; }
        int dev = 0, cus = 0, per_cu = 0;
        (void)hipGetDevice(&dev); (void)hipDeviceGetAttribute(&cus, hipDeviceAttributeMultiprocessorCount, dev);
        if (hipFuncSetAttribute((const void*)mega_fwd, hipFuncAttributeMaxDynamicSharedMemorySize, LDS_BYTES) != hipSuccess) { fprintf(stderr, "kernel_launch: hipFuncSetAttribute failed\n"); grid = -1; return; }
        if (hipOccupancyMaxActiveBlocksPerMultiprocessor(&per_cu, (const void*)mega_fwd, 512, LDS_BYTES) != hipSuccess || per_cu < 1) { fprintf(stderr, "kernel_launch: occupancy query says %d\n", per_cu); per_cu = 1; }
        (void)hipGetLastError();
        grid = cus * 1;
    }
    if (grid < 0) return;
    if (hipMemsetAsync(d_ws, 0, 65536, stream) != hipSuccess) { fprintf(stderr, "kernel_launch: memset of the control words failed\n"); return; }
    Params p{};
    for (int i = 0; i < 28; ++i) p.in[i] = (const float*)d_in[i];
    p.out = (float*)d_out; p.ws = (unsigned char*)d_ws;
    void* args[] = {&p};
    hipError_t e = hipLaunchCooperativeKernel((const void*)mega_fwd, dim3(grid), dim3(512), args, LDS_BYTES, stream);
    if (e != hipSuccess) fprintf(stderr, "cooperative launch failed: %s (grid %d)\n", hipGetErrorString(e), grid);
}
```

```cpp
#include <hip/hip_runtime.h>
#include <hip/hip_cooperative_groups.h>
#include <cstdio>
#include <cstdint>
namespace cg = cooperative_groups;
namespace pg8 {
#define PG8_LAS __attribute__((address_space(3)))
typedef unsigned short bf16_t;
typedef short bf16x8 __attribute__((ext_vector_type(8)));
typedef float f32x4 __attribute__((ext_vector_type(4)));
typedef unsigned u32x4 __attribute__((ext_vector_type(4)));
constexpr int BM = 256, BK = 64, HALF = 128, HTB = HALF * BK * 2  , STAGE_BYTES = 8 * HTB, NXCD = 8, WGM = 4;

__host__ __device__ __forceinline__ int lds_byte(int r, int c) { const int st = (r >> 4) * 2 + (c >> 5), rr = r & 15, cc = c & 31, ob = rr * 64 + cc * 2; return st * 1024 + (ob ^ (((ob >> 9) & 1) << 5)); }
__host__ __device__ __forceinline__ void stage_rc(int b, int& R, int& C) { const int st = b / 1024, sb = b % 1024, swz = sb ^ (((sb >> 9) & 1) << 5); R = (st >> 1) * 16 + swz / 64; C = (st & 1) * 32 + (swz % 64) / 2; }
__host__ __device__ __forceinline__ int perm32(int rho) { const int n = rho >> 4, i = rho & 15; return 8 * (i >> 2) + 4 * n + (i & 3); }

struct Unit { int pm, pn; };
struct Gemm { const bf16_t* A; const bf16_t* Bt; int M, N, K; };

struct StaticOrder {
    int nM, nN, nwg, G, c;
    __host__ __device__ void init(int M, int N, int G_, int c_) { nM = M / BM; nN = N / BM; nwg = nM * nN; G = G_; c = c_; }
    __host__ __device__ bool next(int i, Unit& u) const {
        const long L = (long)i * G + c; if (L >= nwg) return false;
        int wgid = (int)L; { const int q = nwg / NXCD, r = nwg % NXCD, xcd = wgid % NXCD, off = wgid / NXCD; wgid = (xcd < r ? xcd * (q + 1) : r * (q + 1) + (xcd - r) * q) + off; }
        const int nig = WGM * nN, gid = wgid / nig, fm = gid * WGM, gsz = (nM - fm) < WGM ? (nM - fm) : WGM;
        u.pm = fm + ((wgid % nig) % gsz); u.pn = (wgid % nig) / gsz; return true;
    }
    __device__ __forceinline__ void a_ready(const Unit&) const {}
    __device__ __forceinline__ void done(const Unit&) const {}
};
__device__ __forceinline__ unsigned cvt_pk_bf16(float lo, float hi) { unsigned r; asm volatile("v_cvt_pk_bf16_f32 %0, %1, %2" : "=v"(r) : "v"(lo), "v"(hi)); return r; }
typedef float f32x2 __attribute__((ext_vector_type(2)));
template <class Epi, class Sched, bool ALIGN_EPI = false, bool SP2 = false>
__device__ __forceinline__ void gemm_phase(PG8_LAS unsigned char* lds, const Gemm g, const Sched& S, const Epi& E) {
    int tid_o = threadIdx.x; asm volatile("" : "+v"(tid_o));
    const int tid = tid_o, wid = __builtin_amdgcn_readfirstlane(tid >> 6), lane = tid & 63, wr = wid >> 2, wc = wid & 3, fr = lane & 15, fq = lane >> 4;
    const int K = g.K, nt = K / BK;
    unsigned voffA[2], voffB[2];
#pragma unroll
    for (int i = 0; i < 2; ++i) { int R, C; stage_rc(tid * 16 + i * 8192, R, C); const int Rb = Epi::PERM ? ((R & ~31) + perm32(R & 31)) : R;
        voffA[i] = (unsigned)(R * K + C) * 2u; voffB[i] = (unsigned)(Rb * K + C) * 2u; }
    const size_t kstep = (size_t)(BK * 2);
    const size_t hstep = (size_t)HALF * K * 2;
    const size_t tstep = 2 * hstep;
    const unsigned ldsw = (unsigned)wid * 1024u;
    const int aoff = lds_byte(wr * 64 + fr, fq * 8), boff = lds_byte(wc * 32 + fr, fq * 8);
#define PG8_SA(b, h) (((b) * 2 + (h)) * HTB)
#define PG8_SB(b, h) ((4 + (b) * 2 + (h)) * HTB)
#define PG8_STAGE(bufoff, gbase, voff) do { _Pragma("unroll") for (int _i = 0; _i < 2; ++_i) \
        __builtin_amdgcn_global_load_lds((const unsigned*)((const char*)(gbase) + (voff)[_i]), (PG8_LAS unsigned*)(lds + (bufoff) + ldsw + _i * 8192), 16, 0, 0); } while (0)
#define PG8_LDA(dst, b, h) do { _Pragma("unroll") for (int m = 0; m < 4; ++m) _Pragma("unroll") for (int k = 0; k < 2; ++k) dst[m][k] = *(const PG8_LAS bf16x8*)(lds + PG8_SA(b, h) + aoff + m * 2048 + k * 1024); } while (0)
#define PG8_LDB(dst, b, h) do { _Pragma("unroll") for (int n = 0; n < 2; ++n) _Pragma("unroll") for (int k = 0; k < 2; ++k) dst[n][k] = *(const PG8_LAS bf16x8*)(lds + PG8_SB(b, h) + boff + n * 2048 + k * 1024); } while (0)
#define PG8_MMA(ai, bj, At, Bt) do { __builtin_amdgcn_s_setprio(1); _Pragma("unroll") for (int m = 0; m < 4; ++m) _Pragma("unroll") for (int n = 0; n < 2; ++n) _Pragma("unroll") for (int k = 0; k < 2; ++k) \
        acc[ai][bj][m][n] = __builtin_amdgcn_mfma_f32_16x16x32_bf16(Bt[n][k], At[m][k], acc[ai][bj][m][n], 0, 0, 0); __builtin_amdgcn_s_setprio(0); } while (0)
#define PG8_WAIT_V(n) asm volatile("s_waitcnt vmcnt(" #n ")" ::: "memory")
#define PG8_WAIT_L(n) asm volatile("s_waitcnt lgkmcnt(" #n ")" ::: "memory")
#define PG8_BAR __builtin_amdgcn_s_barrier()
#define PG8_SCHED __builtin_amdgcn_sched_barrier(0)
    Unit cur, nxt; int ui = 0;
    if (!S.next(0, cur)) return;
    f32x4 acc[2][2][4][2];
#pragma unroll
    for (int a = 0; a < 2; ++a)
#pragma unroll
        for (int b = 0; b < 2; ++b)
#pragma unroll
            for (int m = 0; m < 4; ++m)
#pragma unroll
                for (int n = 0; n < 2; ++n) acc[a][b][m][n] = (f32x4){0.f, 0.f, 0.f, 0.f};
    bf16x8 At[4][2], B0[2][2], B1[2][2];
    const char* cA = (const char*)g.A + (size_t)cur.pm * tstep; const char* cB = (const char*)g.Bt + (size_t)cur.pn * tstep;
    S.a_ready(cur);
    if constexpr (SP2) {
        PG8_STAGE(PG8_SB(0, 0), cB, voffB); PG8_STAGE(PG8_SB(0, 1), cB + hstep, voffB); PG8_STAGE(PG8_SA(0, 0), cA, voffA); PG8_STAGE(PG8_SA(0, 1), cA + hstep, voffA);
        if (wr == 1) PG8_BAR;
        PG8_WAIT_V(2); PG8_BAR;
        PG8_STAGE(PG8_SB(1, 0), cB + kstep, voffB); PG8_STAGE(PG8_SA(1, 0), cA + kstep, voffA); PG8_STAGE(PG8_SB(1, 1), cB + hstep + kstep, voffB);
        PG8_WAIT_V(6); PG8_BAR;
    } else {
        PG8_STAGE(PG8_SB(0, 0), cB, voffB); PG8_STAGE(PG8_SA(0, 0), cA, voffA); PG8_STAGE(PG8_SB(0, 1), cB + hstep, voffB); PG8_STAGE(PG8_SA(0, 1), cA + hstep, voffA);
        if (wr == 1) PG8_BAR;
        PG8_WAIT_V(4); PG8_BAR;
        PG8_STAGE(PG8_SB(1, 0), cB + kstep, voffB); PG8_STAGE(PG8_SA(1, 0), cA + kstep, voffA); PG8_STAGE(PG8_SB(1, 1), cB + hstep + kstep, voffB);
        PG8_WAIT_V(6); PG8_BAR;
    }
    for (;;) {
        const bool has_next = S.next(ui + 1, nxt);
        const char* nA = has_next ? (const char*)g.A + (size_t)nxt.pm * tstep : cA; const char* nB = has_next ? (const char*)g.Bt + (size_t)nxt.pn * tstep : cB;
        for (int t = 0; t < nt; t += 2) {
            const bool last = (t == nt - 2);
            const char* a1 = cA + (size_t)(t + 1) * kstep;
            const char* a2 = last ? nA : cA + (size_t)(t + 2) * kstep; const char* b2 = last ? nB : cB + (size_t)(t + 2) * kstep;
            const char* a3 = a2 + kstep; const char* b3 = b2 + kstep;
            if (last && has_next) S.a_ready(nxt);
            if constexpr (SP2) {
            PG8_LDB(B0, 0, 0); PG8_LDB(B1, 0, 1); PG8_SCHED; PG8_LDA(At, 0, 0); PG8_STAGE(PG8_SA(1, 1), a1 + hstep, voffA);
            PG8_WAIT_V(8); PG8_WAIT_L(0); PG8_BAR; PG8_MMA(0, 0, At, B0); PG8_MMA(0, 1, At, B1); PG8_BAR; PG8_SCHED;
            PG8_LDA(At, 0, 1); PG8_STAGE(PG8_SB(0, 0), b2, voffB); PG8_STAGE(PG8_SB(0, 1), b2 + hstep, voffB); PG8_STAGE(PG8_SA(0, 0), a2, voffA);
            PG8_WAIT_V(8); PG8_WAIT_L(0); PG8_BAR; PG8_MMA(1, 0, At, B0); PG8_MMA(1, 1, At, B1); PG8_BAR; PG8_SCHED;
            PG8_LDB(B0, 1, 0); PG8_LDB(B1, 1, 1); PG8_SCHED; PG8_LDA(At, 1, 0); PG8_STAGE(PG8_SA(0, 1), a2 + hstep, voffA);
            PG8_WAIT_V(8); PG8_WAIT_L(0); PG8_BAR; PG8_MMA(0, 0, At, B0); PG8_MMA(0, 1, At, B1); PG8_BAR; PG8_SCHED;
            PG8_LDA(At, 1, 1); PG8_STAGE(PG8_SB(1, 0), b3, voffB); PG8_STAGE(PG8_SB(1, 1), b3 + hstep, voffB); PG8_STAGE(PG8_SA(1, 0), a3, voffA);
            PG8_WAIT_V(8); PG8_WAIT_L(0); PG8_BAR; PG8_MMA(1, 0, At, B0); PG8_MMA(1, 1, At, B1); PG8_BAR; PG8_SCHED;
            } else {
            PG8_LDB(B0, 0, 0); PG8_SCHED; PG8_LDA(At, 0, 0); PG8_STAGE(PG8_SA(1, 1), a1 + hstep, voffA);
            PG8_WAIT_L(8); PG8_BAR; PG8_WAIT_L(0); PG8_MMA(0, 0, At, B0); PG8_BAR; PG8_SCHED;
            PG8_LDB(B1, 0, 1); PG8_STAGE(PG8_SB(0, 0), b2, voffB);
            PG8_BAR; PG8_WAIT_L(0); PG8_MMA(0, 1, At, B1); PG8_BAR;
            PG8_LDA(At, 0, 1); PG8_STAGE(PG8_SA(0, 0), a2, voffA);
            PG8_BAR; PG8_WAIT_L(0); PG8_MMA(1, 0, At, B0); PG8_BAR; PG8_SCHED;
            PG8_STAGE(PG8_SB(0, 1), b2 + hstep, voffB);
            PG8_WAIT_V(6); PG8_BAR; PG8_MMA(1, 1, At, B1); PG8_BAR;
            PG8_LDB(B0, 1, 0); PG8_SCHED; PG8_LDA(At, 1, 0); PG8_STAGE(PG8_SA(0, 1), a2 + hstep, voffA);
            PG8_WAIT_L(8); PG8_BAR; PG8_WAIT_L(0); PG8_MMA(0, 0, At, B0); PG8_BAR; PG8_SCHED;
            PG8_LDB(B1, 1, 1); PG8_STAGE(PG8_SB(1, 0), b3, voffB);
            PG8_BAR; PG8_WAIT_L(0); PG8_MMA(0, 1, At, B1); PG8_BAR;
            PG8_LDA(At, 1, 1); PG8_STAGE(PG8_SA(1, 0), a3, voffA);
            PG8_BAR; PG8_WAIT_L(0); PG8_MMA(1, 0, At, B0); PG8_BAR; PG8_SCHED;
            PG8_STAGE(PG8_SB(1, 1), b3 + hstep, voffB);
            PG8_WAIT_V(6); PG8_BAR; PG8_MMA(1, 1, At, B1); PG8_BAR;
            }
        }
        if constexpr (ALIGN_EPI) { if (wr == 0) PG8_BAR; }
        if constexpr (!Epi::AFTER_DRAIN) { E(acc, cur, wr, wc, fr, fq); S.done(cur); }
        if (!has_next) break;
#pragma unroll
        for (int a = 0; a < 2; ++a)
#pragma unroll
            for (int b = 0; b < 2; ++b)
#pragma unroll
                for (int m = 0; m < 4; ++m)
#pragma unroll
                    for (int n = 0; n < 2; ++n) acc[a][b][m][n] = (f32x4){0.f, 0.f, 0.f, 0.f};
        cur = nxt; cA = nA; cB = nB; ++ui;
        if constexpr (ALIGN_EPI) { if (wr == 1) PG8_BAR; }
    }
    PG8_WAIT_V(0);
    if constexpr (!ALIGN_EPI) { if (wr == 0) PG8_BAR; }
    PG8_BAR;
    if constexpr (Epi::AFTER_DRAIN) { E.fused(acc, cur, wr, wc, fr, fq, lds, wid, lane); S.done(cur); }
#undef PG8_SA
#undef PG8_SB
#undef PG8_STAGE
#undef PG8_LDA
#undef PG8_LDB
#undef PG8_MMA
#undef PG8_WAIT_V
#undef PG8_WAIT_L
#undef PG8_BAR
#undef PG8_SCHED
}
}

#define LAS __attribute__((address_space(3)))
using pg8::bf16_t; using pg8::f32x4; using pg8::u32x4; using pg8::Unit; using pg8::cvt_pk_bf16;
typedef short bf16x8 __attribute__((ext_vector_type(8)));
typedef float f32x16 __attribute__((ext_vector_type(16)));
typedef unsigned u32x2 __attribute__((ext_vector_type(2)));
typedef short v4i16_t __attribute__((ext_vector_type(4)));

constexpr int M_TOK = 16384, SEQ = 4096, DM = 2048, DFF = 5632, NWIN = 3584;
constexpr float EPS = 1e-6f, LOG2E = 1.4426950408889634f;
constexpr float QSCALE = 0.07216878364870322f * 1.4426950408889634f;
constexpr float SBSCALE = 0.08838834764831845f * 1.4426950408889634f;

constexpr size_t MiB = 1u << 20;
constexpr size_t WS_CTL = 0, WS_RSTD = 512 * 1024;
constexpr size_t WS_W = 1 * MiB, W_LAYER = 167 * MiB;
constexpr size_t WO_FF1IN = 0, WO_FF1OUT = 44 * MiB, WO_IN = 66 * MiB, WO_UQ = 80 * MiB, WO_UKV = 82 * MiB, WO_PW = 83 * MiB,
                 WO_OUT = 84 * MiB, WO_FF2IN = 92 * MiB, WO_FF2OUT = 136 * MiB, WO_GATE = 158 * MiB, WO_PROJ = 166 * MiB;
static_assert(WO_PROJ + 2048 * 256 * 2 <= W_LAYER, "weights map");
constexpr size_t WS_HID = 335 * MiB;
constexpr size_t WS_CQ = WS_HID, WS_CKV = WS_HID + 16 * MiB, WS_GLU = WS_HID + 24 * MiB, WS_SBQ = WS_HID + 40 * MiB, WS_SBK = WS_HID + 56 * MiB,
                 WS_SBV = WS_HID + 72 * MiB, WS_KR = WS_HID + 88 * MiB, WS_SSQ = WS_HID + 90 * MiB, WS_MIX = WS_HID + 91 * MiB;
static_assert(WS_MIX + 64 * MiB <= WS_HID + 176 * MiB && WS_SBV - WS_SBK == WS_SBK - WS_SBQ, "hid overlay");
constexpr size_t WS_F = 511 * MiB;
constexpr size_t WS_Q = WS_F, WS_KN = WS_F + 48 * MiB, WS_V = WS_F + 80 * MiB, WS_CV = WS_F + 112 * MiB;
constexpr size_t WS_XN = 639 * MiB;
constexpr size_t WS_PB = 703 * MiB;
constexpr size_t WS_COS = 719 * MiB, WS_SIN = 721 * MiB;
constexpr size_t WS_EB = 723 * MiB;
constexpr size_t WS_END = 787 * MiB;

constexpr int LDS_BYTES = 147456;
constexpr int MISC_OFF = 131072;
constexpr int CW_BAR = 4096;

__device__ __forceinline__ int otid() { int t = threadIdx.x; asm volatile("" : "+v"(t)); return t; }
__device__ __forceinline__ float wave_sum(float v) {
#pragma unroll
    for (int o = 1; o < 64; o <<= 1) v += __shfl_xor(v, o);
    return v;
}
__device__ __forceinline__ float fexp2(float x) { return __builtin_amdgcn_exp2f(x); }
__device__ __forceinline__ float frcp(float x) { return __builtin_amdgcn_rcpf(x); }
__device__ __forceinline__ float sigmoidf_(float x) { return frcp(1.0f + fexp2(-x * LOG2E)); }
__device__ __forceinline__ void st8(bf16_t* p, f32x4 v0, f32x4 v1) {
    u32x4 w; w.x = cvt_pk_bf16(v0[0], v0[1]); w.y = cvt_pk_bf16(v0[2], v0[3]); w.z = cvt_pk_bf16(v1[0], v1[1]); w.w = cvt_pk_bf16(v1[2], v1[3]);
    *(u32x4*)p = w;
}
__device__ __forceinline__ void st4(bf16_t* p, f32x4 v) { u32x2 w; w.x = cvt_pk_bf16(v[0], v[1]); w.y = cvt_pk_bf16(v[2], v[3]); *(u32x2*)p = w; }
__device__ __forceinline__ float dot4(f32x4 a) { return (a[0] * a[0] + a[1] * a[1]) + (a[2] * a[2] + a[3] * a[3]); }

#define EPI_ROWS for (int ai = 0; ai < 2; ++ai) _Pragma("unroll") for (int m = 0; m < 4; ++m)
#define LOAD_RS(rsv, ptr, row0) float rsv[2][4]; _Pragma("unroll") for (int ai = 0; ai < 2; ++ai) _Pragma("unroll") for (int m = 0; m < 4; ++m) rsv[ai][m] = (ptr)[(row0) + ai * 128 + m * 16];
struct EpiSwiglu {
    static constexpr bool PERM = true, AFTER_DRAIN = false;
    bf16_t* H; const float* rstd;
    __device__ __forceinline__ void operator()(const f32x4 (&acc)[2][2][4][2], const Unit& u, int wr, int wc, int fr, int fq) const {
        asm volatile("" : "+v"(fr), "+v"(fq));
        const int row0 = u.pm * 256 + wr * 64 + fr, col = u.pn * 128 + wc * 32 + 8 * fq;
        LOAD_RS(rsv, rstd, row0)
#pragma unroll
        EPI_ROWS { const int row = row0 + ai * 128 + m * 16; const float rs = rsv[ai][m]; f32x4 o[2];
#pragma unroll
            for (int n = 0; n < 2; ++n) { const f32x4 a = acc[ai][0][m][n] * rs, g = acc[ai][1][m][n] * rs;
#pragma unroll
                for (int e = 0; e < 4; ++e) o[n][e] = a[e] * sigmoidf_(a[e]) * g[e]; }
            st8(H + (size_t)row * DFF + col, o[0], o[1]); }
    }
};
struct EpiF32 {
    static constexpr bool PERM = true, AFTER_DRAIN = false;
    float* O; int ldc;
    __device__ __forceinline__ void operator()(const f32x4 (&acc)[2][2][4][2], const Unit& u, int wr, int wc, int fr, int fq) const {
        asm volatile("" : "+v"(fr), "+v"(fq));
        const int row0 = u.pm * 256 + wr * 64 + fr, col = u.pn * 256 + wc * 32 + 8 * fq;
#pragma unroll
        EPI_ROWS { float* p = O + (size_t)(row0 + ai * 128 + m * 16) * ldc + col;
#pragma unroll
            for (int bj = 0; bj < 2; ++bj) { *(f32x4*)(p + bj * 128) = acc[ai][bj][m][0]; *(f32x4*)(p + bj * 128 + 4) = acc[ai][bj][m][1]; } }
    }
};
struct EpiBf {
    static constexpr bool PERM = true, AFTER_DRAIN = false;
    bf16_t* O; int ldc;
    __device__ __forceinline__ void operator()(const f32x4 (&acc)[2][2][4][2], const Unit& u, int wr, int wc, int fr, int fq) const {
        asm volatile("" : "+v"(fr), "+v"(fq));
        const int row0 = u.pm * 256 + wr * 64 + fr, col = u.pn * 256 + wc * 32 + 8 * fq;
#pragma unroll
        EPI_ROWS { bf16_t* p = O + (size_t)(row0 + ai * 128 + m * 16) * ldc + col;
#pragma unroll
            for (int bj = 0; bj < 2; ++bj) st8(p + bj * 128, acc[ai][bj][m][0], acc[ai][bj][m][1]); }
    }
};
struct EpiGate {
    static constexpr bool PERM = true, AFTER_DRAIN = false;
    bf16_t* O; const bf16_t* Eb; const float* rstd;
    __device__ __forceinline__ void operator()(const f32x4 (&acc)[2][2][4][2], const Unit& u, int wr, int wc, int fr, int fq) const {
        asm volatile("" : "+v"(fr), "+v"(fq));
        const int row0 = u.pm * 256 + wr * 64 + fr, col = u.pn * 256 + wc * 32 + 8 * fq;
        LOAD_RS(rsv, rstd, row0)
#pragma unroll
        EPI_ROWS { const int row = row0 + ai * 128 + m * 16; const float rs = rsv[ai][m]; const size_t off = (size_t)row * DM + col;
#pragma unroll
            for (int bj = 0; bj < 2; ++bj) { const u32x4 ev = *(const u32x4*)(Eb + off + bj * 128); f32x4 o0, o1;
                const f32x4 a0 = acc[ai][bj][m][0] * rs, a1 = acc[ai][bj][m][1] * rs;
                o0[0] = sigmoidf_(a0[0]) * __uint_as_float(ev.x << 16); o0[1] = sigmoidf_(a0[1]) * __uint_as_float(ev.x & 0xffff0000u);
                o0[2] = sigmoidf_(a0[2]) * __uint_as_float(ev.y << 16); o0[3] = sigmoidf_(a0[3]) * __uint_as_float(ev.y & 0xffff0000u);
                o1[0] = sigmoidf_(a1[0]) * __uint_as_float(ev.z << 16); o1[1] = sigmoidf_(a1[1]) * __uint_as_float(ev.z & 0xffff0000u);
                o1[2] = sigmoidf_(a1[2]) * __uint_as_float(ev.w << 16); o1[3] = sigmoidf_(a1[3]) * __uint_as_float(ev.w & 0xffff0000u);
                st8(O + off + bj * 128, o0, o1); } }
    }
};
struct EpiWin {
    static constexpr bool PERM = true, AFTER_DRAIN = false;
    unsigned char* wsb;
    __device__ __forceinline__ void operator()(const f32x4 (&acc)[2][2][4][2], const Unit& u, int wr, int wc, int fr, int fq) const {
        asm volatile("" : "+v"(fr), "+v"(fq));
        const int pn = u.pn, row0 = u.pm * 256 + wr * 64 + fr, cw = wc * 32 + 8 * fq;
        bf16_t* glu = (bf16_t*)(wsb + WS_GLU); bf16_t* kr = (bf16_t*)(wsb + WS_KR); float* ssq = (float*)(wsb + WS_SSQ);
        const float* rstd = (const float*)(wsb + WS_RSTD);
        LOAD_RS(rsv, rstd, row0)
        const float* ccos = (const float*)(wsb + WS_COS); const float* csin = (const float*)(wsb + WS_SIN);
        if (pn <= 2) {
            bf16_t* base = (bf16_t*)(wsb + (pn < 2 ? WS_CQ : WS_CKV)); const int ld = pn < 2 ? 512 : 256, cb = (pn == 1 ? 256 : 0) + cw;
#pragma unroll
            EPI_ROWS { const int row = row0 + ai * 128 + m * 16; const float rs = rsv[ai][m]; float ss = 0.f;
#pragma unroll
                for (int bj = 0; bj < 2; ++bj) { const f32x4 v0 = acc[ai][bj][m][0] * rs, v1 = acc[ai][bj][m][1] * rs; st8(base + (size_t)row * ld + cb + bj * 128, v0, v1); ss += dot4(v0) + dot4(v1); }
                ss += __shfl_xor(ss, 16); ss += __shfl_xor(ss, 32);
                if (fq == 0) ssq[(size_t)row * 12 + pn * 4 + wc] = ss; }
        } else if (pn <= 6) {
            const int col = (pn - 3) * 128 + cw;
#pragma unroll
            EPI_ROWS { const int row = row0 + ai * 128 + m * 16; const float rs = rsv[ai][m]; f32x4 o[2];
#pragma unroll
                for (int n = 0; n < 2; ++n) { const f32x4 a = acc[ai][0][m][n] * rs, g = acc[ai][1][m][n] * rs;
#pragma unroll
                    for (int e = 0; e < 4; ++e) o[n][e] = a[e] * sigmoidf_(g[e]); }
                st8(glu + (size_t)row * 512 + col, o[0], o[1]); }
        } else if (pn <= 12) {
            const int which = (pn - 7) >> 1; bf16_t* base = (bf16_t*)(wsb + WS_SBQ + (size_t)which * (WS_SBK - WS_SBQ)); const float sc = which == 0 ? SBSCALE : 1.0f;
            const int cb = ((pn - 7) & 1) * 256 + cw;
#pragma unroll
            EPI_ROWS { const int row = row0 + ai * 128 + m * 16; const float rs = rsv[ai][m] * sc;
#pragma unroll
                for (int bj = 0; bj < 2; ++bj) st8(base + (size_t)row * 512 + cb + bj * 128, acc[ai][bj][m][0] * rs, acc[ai][bj][m][1] * rs); }
        } else {
            if (wc == 0) {
#pragma unroll
                EPI_ROWS { const int row = row0 + ai * 128 + m * 16;
#pragma unroll
                    for (int n = 0; n < 2; ++n) { const int j0 = 8 * fq + 4 * n; const f32x4 c4 = *(const f32x4*)(ccos + (size_t)row * 32 + j0), s4 = *(const f32x4*)(csin + (size_t)row * 32 + j0);
                        const float rs = rsv[ai][m]; const f32x4 x1 = acc[ai][0][m][n] * rs, x2 = acc[ai][1][m][n] * rs;
                        st4(kr + (size_t)row * 64 + j0, x1 * c4 - x2 * s4); st4(kr + (size_t)row * 64 + 32 + j0, x1 * s4 + x2 * c4); } }
            }
        }
    }
};
struct EpiUq {
    static constexpr bool PERM = true, AFTER_DRAIN = false;
    bf16_t* Q; const float* ssq; const float* ccos; const float* csin;
    __device__ __forceinline__ void operator()(const f32x4 (&acc)[2][2][4][2], const Unit& u, int wr, int wc, int fr, int fq) const {
        asm volatile("" : "+v"(fr), "+v"(fq));
        const int pn = u.pn, row0 = u.pm * 256 + wr * 64 + fr, cw = wc * 32 + 8 * fq;
#pragma unroll
        for (int ai = 0; ai < 2; ++ai) {
        f32x4 pa[4], pb[4];
#pragma unroll
        for (int m = 0; m < 4; ++m) { const int row = row0 + ai * 128 + m * 16; pa[m] = *(const f32x4*)(ssq + (size_t)row * 12); pb[m] = *(const f32x4*)(ssq + (size_t)row * 12 + 4); }
#pragma unroll
        for (int m = 0; m < 4; ++m) { const int row = row0 + ai * 128 + m * 16;
            const f32x4 p0 = pa[m], p1 = pb[m];
            const float s = ((p0[0] + p0[1]) + (p0[2] + p0[3])) + ((p1[0] + p1[1]) + (p1[2] + p1[3]));
            const float rs = rsqrtf(s * (1.0f / 512.0f) + EPS) * QSCALE;
            if (pn < 4) {
#pragma unroll
                for (int bj = 0; bj < 2; ++bj) st8(Q + (size_t)row * 1536 + (2 * pn + bj) * 192 + cw, acc[ai][bj][m][0] * rs, acc[ai][bj][m][1] * rs);
            } else {
                bf16_t* qh = Q + (size_t)row * 1536 + (4 * (pn - 4) + wc) * 192 + 128;
#pragma unroll
                for (int n = 0; n < 2; ++n) { const int j0 = 8 * fq + 4 * n; const f32x4 c4 = *(const f32x4*)(ccos + (size_t)row * 32 + j0), s4 = *(const f32x4*)(csin + (size_t)row * 32 + j0);
                    const f32x4 x1 = acc[ai][0][m][n] * rs, x2 = acc[ai][1][m][n] * rs;
                    st4(qh + j0, x1 * c4 - x2 * s4); st4(qh + 32 + j0, x1 * s4 + x2 * c4); }
            }
        }
        }
    }
};
struct EpiUkv {
    static constexpr bool PERM = true, AFTER_DRAIN = false;
    bf16_t* Kn; bf16_t* V; const float* ssq;
    __device__ __forceinline__ void operator()(const f32x4 (&acc)[2][2][4][2], const Unit& u, int wr, int wc, int fr, int fq) const {
        asm volatile("" : "+v"(fr), "+v"(fq));
        const int row0 = u.pm * 256 + wr * 64 + fr, col = u.pn * 128 + wc * 32 + 8 * fq;
        f32x4 pa[2][4];
#pragma unroll
        EPI_ROWS { pa[ai][m] = *(const f32x4*)(ssq + (size_t)(row0 + ai * 128 + m * 16) * 12 + 8); }
#pragma unroll
        EPI_ROWS { const int row = row0 + ai * 128 + m * 16;
            const f32x4 p0 = pa[ai][m];
            const float rs = rsqrtf(((p0[0] + p0[1]) + (p0[2] + p0[3])) * (1.0f / 256.0f) + EPS);
            st8(Kn + (size_t)row * 1024 + col, acc[ai][0][m][0] * rs, acc[ai][0][m][1] * rs);
            st8(V + (size_t)row * 1024 + col, acc[ai][1][m][0] * rs, acc[ai][1][m][1] * rs); }
    }
};

namespace att {
constexpr int ST_KN = 0, ST_V = 16384, ST_KR = 32768, ST_BYTES = 40960;
__device__ __forceinline__ int offb(int row, int ch) { return 256 * row + 16 * (ch ^ (((row & 3) << 2) | ((row >> 2) & 3))); }
__device__ __forceinline__ int off64(int row, int ch) { return 128 * row + 16 * (ch ^ ((row >> 1) & 7)); }
__device__ __forceinline__ bf16x8 mk8(v4i16_t lo, v4i16_t hi) { return (bf16x8){lo[0], lo[1], lo[2], lo[3], hi[0], hi[1], hi[2], hi[3]}; }
__device__ __forceinline__ v4i16_t trrd(LAS unsigned char* p) { return __builtin_amdgcn_ds_read_tr16_b64_v4i16((LAS v4i16_t*)p); }
__device__ __forceinline__ bf16x8 pack8(float a0, float a1, float a2, float a3, float a4, float a5, float a6, float a7) {
    u32x4 w; w.x = cvt_pk_bf16(a0, a1); w.y = cvt_pk_bf16(a2, a3); w.z = cvt_pk_bf16(a4, a5); w.w = cvt_pk_bf16(a6, a7);
    return __builtin_bit_cast(bf16x8, w);
}
__device__ __forceinline__ void pair32(float v, float& lo, float& hi_) { const auto rr = __builtin_amdgcn_permlane32_swap(__float_as_uint(v), __float_as_uint(v), false, false); lo = __uint_as_float(rr[0]); hi_ = __uint_as_float(rr[1]); }
__device__ __forceinline__ void sb_block(f32x16& S, float& running, int hi) {
#pragma unroll
    for (int gq = 3; gq >= 0; --gq) {
        float bt[4], kp[4];
#pragma unroll
        for (int e = 0; e < 4; ++e) { const float ee = fexp2(-S[4 * gq + e]); bt[e] = frcp(1.0f + ee); kp[e] = 1.0f - bt[e]; }
        const float own = (kp[0] * kp[1]) * (kp[2] * kp[3]); float plo, phi; pair32(own, plo, phi);
        float E = running * (hi ? 1.0f : phi);
        S[4 * gq + 3] = bt[3] * E; E *= kp[3];
        S[4 * gq + 2] = bt[2] * E; E *= kp[2];
        S[4 * gq + 1] = bt[1] * E; E *= kp[1];
        S[4 * gq + 0] = bt[0] * E;
        running *= plo * phi;
    }
}

template <bool SB>
__device__ __forceinline__ void attn_unit(LAS unsigned char* lds, const bf16_t* __restrict__ Q, int qp, const bf16_t* __restrict__ K, int kp,
                                          const bf16_t* __restrict__ V, int vp, const bf16_t* __restrict__ KR, bf16_t* O, int tokbase, int qblk) {
    constexpr int NDN = 8, NDR = SB ? 0 : 4, ND = NDN + NDR;
    const int tid = otid(), lane = tid & 63, wid = __builtin_amdgcn_readfirstlane(tid >> 6), r32 = lane & 31, hi = lane >> 5;
    const bool lead = wid < 4;
    const int qw0 = qblk * 256 + wid * 32, tq = qw0 + r32;
    bf16x8 qf[ND];
    { const bf16_t* qrow = Q + (size_t)(tokbase + tq) * qp + 8 * hi;
#pragma unroll
      for (int ds = 0; ds < ND; ++ds) qf[ds] = *(const bf16x8*)(qrow + 16 * ds); }
    f32x16 o[4];
#pragma unroll
    for (int d0 = 0; d0 < 4; ++d0)
#pragma unroll
        for (int r = 0; r < 16; ++r) o[d0][r] = 0.f;
    float m_run = -1e30f, l_run = 0.f, running = 1.0f;
    const int NT = (qblk + 1) * 4;
    const bf16_t* gK; const bf16_t* gV; const bf16_t* gR = nullptr;
    { const int row = 4 * wid + (lane >> 4), ch = (lane & 15) ^ (((row & 3) << 2) | ((row >> 2) & 3));
      gK = K + (size_t)(tokbase + row) * kp + ch * 8; gV = V + (size_t)(tokbase + row) * vp + ch * 8;
      if (!SB) { const int rr = 8 * wid + (lane >> 3), cr = (lane & 7) ^ ((rr >> 1) & 7); gR = KR + (size_t)(tokbase + rr) * 64 + cr * 8; } }
    const unsigned pcs = (unsigned)wid * 1024u;
#define ATT_DMA(T, stw) do { const size_t ko = (size_t)(T) * 64 * kp, vo = (size_t)(T) * 64 * vp; \
        __builtin_amdgcn_global_load_lds((const unsigned*)(gK + ko), (LAS unsigned*)((stw) + ST_KN + pcs), 16, 0, 0); \
        __builtin_amdgcn_global_load_lds((const unsigned*)(gK + ko + (size_t)32 * kp), (LAS unsigned*)((stw) + ST_KN + 8192 + pcs), 16, 0, 0); \
        __builtin_amdgcn_global_load_lds((const unsigned*)(gV + vo), (LAS unsigned*)((stw) + ST_V + pcs), 16, 0, 0); \
        __builtin_amdgcn_global_load_lds((const unsigned*)(gV + vo + (size_t)32 * vp), (LAS unsigned*)((stw) + ST_V + 8192 + pcs), 16, 0, 0); \
        if (!SB) __builtin_amdgcn_global_load_lds((const unsigned*)(gR + (size_t)(T) * 64 * 64), (LAS unsigned*)((stw) + ST_KR + pcs), 16, 0, 0); } while (0)
#define ATT_BAR(more) do { if (more) { if (SB) asm volatile("s_waitcnt vmcnt(4) lgkmcnt(0)" ::: "memory"); else asm volatile("s_waitcnt vmcnt(5) lgkmcnt(0)" ::: "memory"); } \
        else asm volatile("s_waitcnt vmcnt(0) lgkmcnt(0)" ::: "memory"); __builtin_amdgcn_s_barrier(); asm volatile("" ::: "memory"); } while (0)
#define ATT_SB() __builtin_amdgcn_sched_barrier(0)
#define ATT_TILE(t_) (SB ? NT - 1 - (t_) : (t_))
    const int xk = ((r32 & 3) << 2) | ((r32 >> 2) & 3);
    const int krow = 256 * r32, rrw = 128 * r32, xr = (r32 >> 1) & 7;
    const int g4 = lane >> 4, tq4 = (lane & 15) >> 2, tp = lane & 3;
    f32x16 s0, s1;
#define ATT_KFRAG(dst, i, ds, stq) do { if ((ds) < NDN) { const int co = 16 * ((2 * (ds) + hi) ^ xk); \
            dst[2 * (i)] = *(const LAS bf16x8*)((stq) + ST_KN + krow + co); dst[2 * (i) + 1] = *(const LAS bf16x8*)((stq) + ST_KN + 8192 + krow + co); } \
        else { const int co = 16 * ((2 * ((ds) - NDN) + hi) ^ xr); \
            dst[2 * (i)] = *(const LAS bf16x8*)((stq) + ST_KR + rrw + co); dst[2 * (i) + 1] = *(const LAS bf16x8*)((stq) + ST_KR + 4096 + rrw + co); } } while (0)
#define ATT_QK(stq) do { \
        _Pragma("unroll") for (int r = 0; r < 16; ++r) { s0[r] = 0.f; s1[r] = 0.f; } \
        bf16x8 fa[4], fb[4]; \
        ATT_KFRAG(fa, 0, 0, stq); ATT_KFRAG(fa, 1, 1, stq); ATT_SB(); \
        _Pragma("unroll") for (int b = 0; b < ND / 2; b += 2) { \
            if (b + 1 < ND / 2) { ATT_KFRAG(fb, 0, 2 * b + 2, stq); ATT_KFRAG(fb, 1, 2 * b + 3, stq); } ATT_SB(); \
            s0 = __builtin_amdgcn_mfma_f32_32x32x16_bf16(fa[0], qf[2 * b], s0, 0, 0, 0); s1 = __builtin_amdgcn_mfma_f32_32x32x16_bf16(fa[1], qf[2 * b], s1, 0, 0, 0); \
            s0 = __builtin_amdgcn_mfma_f32_32x32x16_bf16(fa[2], qf[2 * b + 1], s0, 0, 0, 0); s1 = __builtin_amdgcn_mfma_f32_32x32x16_bf16(fa[3], qf[2 * b + 1], s1, 0, 0, 0); ATT_SB(); \
            if (b + 1 < ND / 2) { \
                if (b + 2 < ND / 2) { ATT_KFRAG(fa, 0, 2 * b + 4, stq); ATT_KFRAG(fa, 1, 2 * b + 5, stq); } ATT_SB(); \
                s0 = __builtin_amdgcn_mfma_f32_32x32x16_bf16(fb[0], qf[2 * b + 2], s0, 0, 0, 0); s1 = __builtin_amdgcn_mfma_f32_32x32x16_bf16(fb[1], qf[2 * b + 2], s1, 0, 0, 0); \
                s0 = __builtin_amdgcn_mfma_f32_32x32x16_bf16(fb[2], qf[2 * b + 3], s0, 0, 0, 0); s1 = __builtin_amdgcn_mfma_f32_32x32x16_bf16(fb[3], qf[2 * b + 3], s1, 0, 0, 0); ATT_SB(); } } \
    } while (0)
#define ATT_VFRAG(dst, ks, stv) do { \
        _Pragma("unroll") for (int d0 = 0; d0 < 4; ++d0) { \
            const int c = 4 * d0 + 2 * (g4 & 1) + (tp >> 1); \
            const int rowa = 4 * (g4 >> 1) + tq4, rowb = rowa + 8; \
            const int a0 = 256 * rowa + 16 * (c ^ (((rowa & 3) << 2) | ((rowa >> 2) & 3))) + 8 * (tp & 1); \
            const int a1 = 256 * rowb + 16 * (c ^ (((rowb & 3) << 2) | ((rowb >> 2) & 3))) + 8 * (tp & 1); \
            dst[d0] = mk8(trrd((stv) + ST_V + a0 + (ks) * 4096), trrd((stv) + ST_V + a1 + (ks) * 4096)); } } while (0)
#define ATT_SMPV(k0v, stv) do { \
        const int k0_ = (k0v); \
        bf16x8 va[4], vb[4]; \
        ATT_VFRAG(va, 0, stv); ATT_SB(); \
        if (k0_ + 63 >= qw0) { asm volatile("; tile on the causal diagonal: mask" ::: "memory");     \
            _Pragma("unroll") for (int r = 0; r < 16; ++r) { const int kv = k0_ + (r & 3) + 8 * (r >> 2) + 4 * hi + (SB ? 1 : 0); if (kv > tq) s0[r] = -1e30f; if (kv + 32 > tq) s1[r] = -1e30f; } } \
        if (SB) { sb_block(s1, running, hi); sb_block(s0, running, hi); } \
        else { \
            asm volatile("s_nop 15\n\ts_nop 7" : "+v"(s0), "+v"(s1));     \
            float mx; asm("v_max_f32_e32 %0, %1, %2" : "=v"(mx) : "v"(s0[0]), "v"(s1[0])); \
            _Pragma("unroll") for (int r = 1; r < 16; ++r) asm("v_max3_f32 %0, %1, %2, %3" : "=v"(mx) : "v"(mx), "v"(s0[r]), "v"(s1[r]));     \
            { float mlo, mhi; pair32(mx, mlo, mhi); mx = fmaxf(mlo, mhi); } \
            const bool grew = mx > m_run + 4.0f;     \
            const float mn = grew ? mx : m_run, alpha = fexp2(m_run - mn); \
            m_run = mn; \
            float ls = 0.f; \
            _Pragma("unroll") for (int r = 0; r < 16; ++r) { s0[r] = fexp2(s0[r] - mn); s1[r] = fexp2(s1[r] - mn); ls += s0[r] + s1[r]; } \
            l_run = l_run * alpha + ls; \
            if (__any(grew)) { _Pragma("unroll") for (int d0 = 0; d0 < 4; ++d0) _Pragma("unroll") for (int r = 0; r < 16; ++r) o[d0][r] *= alpha; } \
        } \
        bf16x8 pf[4]; \
        pf[0] = pack8(s0[0], s0[1], s0[2], s0[3], s0[4], s0[5], s0[6], s0[7]); \
        pf[1] = pack8(s0[8], s0[9], s0[10], s0[11], s0[12], s0[13], s0[14], s0[15]); \
        pf[2] = pack8(s1[0], s1[1], s1[2], s1[3], s1[4], s1[5], s1[6], s1[7]); \
        pf[3] = pack8(s1[8], s1[9], s1[10], s1[11], s1[12], s1[13], s1[14], s1[15]); \
        ATT_SB(); ATT_VFRAG(vb, 1, stv); ATT_SB(); \
        _Pragma("unroll") for (int d0 = 0; d0 < 4; ++d0) o[d0] = __builtin_amdgcn_mfma_f32_32x32x16_bf16(va[d0], pf[0], o[d0], 0, 0, 0); \
        ATT_SB(); ATT_VFRAG(va, 2, stv); ATT_SB(); \
        _Pragma("unroll") for (int d0 = 0; d0 < 4; ++d0) o[d0] = __builtin_amdgcn_mfma_f32_32x32x16_bf16(vb[d0], pf[1], o[d0], 0, 0, 0); \
        ATT_SB(); ATT_VFRAG(vb, 3, stv); ATT_SB(); \
        _Pragma("unroll") for (int d0 = 0; d0 < 4; ++d0) o[d0] = __builtin_amdgcn_mfma_f32_32x32x16_bf16(va[d0], pf[2], o[d0], 0, 0, 0); \
        ATT_SB(); \
        _Pragma("unroll") for (int d0 = 0; d0 < 4; ++d0) o[d0] = __builtin_amdgcn_mfma_f32_32x32x16_bf16(vb[d0], pf[3], o[d0], 0, 0, 0); \
    } while (0)
    ATT_DMA(ATT_TILE(0), lds);
    ATT_DMA(ATT_TILE(1), lds + ST_BYTES);
    ATT_BAR(true);
    if (!lead) ATT_BAR(true);
    int cur = 0;
    for (int t = 0; t < NT; ++t) {
        LAS unsigned char* stc = lds + cur * ST_BYTES;
        LAS unsigned char* stn = lds + (cur == 0 ? 2 : cur - 1) * ST_BYTES;
        const int k0 = ATT_TILE(t) * 64;
        const bool act = (k0 <= qw0 + 31);
        const bool more = t + 2 < NT;
        if (!lead && more) ATT_DMA(ATT_TILE(t + 2), stn);
        if (act) { ATT_QK(stc); }
        ATT_BAR(lead ? (t + 1 < NT) : more);
        if (lead && more) ATT_DMA(ATT_TILE(t + 2), stn);
        if (act) { ATT_SMPV(k0, stc); }
        ATT_BAR(more);
        cur = (cur == 2) ? 0 : cur + 1;
    }
    if (lead) ATT_BAR(false);
#undef ATT_DMA
#undef ATT_BAR
#undef ATT_SB
#undef ATT_TILE
#undef ATT_KFRAG
#undef ATT_QK
#undef ATT_VFRAG
#undef ATT_SMPV
    float inv = 1.0f;
    if (!SB) { float llo, lhi; pair32(l_run, llo, lhi); inv = 1.0f / (llo + lhi); }
    bf16_t* orow = O + (size_t)(tokbase + tq) * DM + 4 * hi;
#pragma unroll
    for (int d0 = 0; d0 < 4; ++d0)
#pragma unroll
        for (int gq = 0; gq < 4; ++gq) {
            f32x4 v; v[0] = o[d0][4 * gq] * inv; v[1] = o[d0][4 * gq + 1] * inv; v[2] = o[d0][4 * gq + 2] * inv; v[3] = o[d0][4 * gq + 3] * inv;
            st4(orow + 32 * d0 + 8 * gq, v);
        }
}
}

__device__ __forceinline__ int srccol(int mode, int nb) {
    if (mode == 0) return 32 * nb;
    if (mode == 1) { const int pn = nb >> 3, q = nb & 7; return (q >> 2) * DFF + 128 * pn + 32 * (q & 3); }
    if (mode == 2) {
        if (nb < 16) return 32 * nb;
        if (nb < 24) return 512 + 32 * (nb - 16);
        if (nb < 56) { const int t = (nb - 24) >> 3, q = (nb - 24) & 7; return 832 + (q >> 2) * 512 + 128 * t + 32 * (q & 3); }
        if (nb < 104) return 1856 + 32 * (nb - 56);
        if (nb == 104) return 768;
        if (nb == 108) return 800;
        return -1;
    }
    if (nb < 32) return 192 * (nb >> 2) + 32 * (nb & 3);
    { const int t = (nb - 32) >> 3, q = (nb - 32) & 7; return 192 * (4 * t + (q & 3)) + 128 + 32 * (q >> 2); }
}
__device__ __forceinline__ unsigned f2bf(float f) { unsigned u = __builtin_bit_cast(unsigned, f); return (u + 0x7fffu + ((u >> 16) & 1u)) >> 16; }
__device__ __forceinline__ unsigned pk2(float lo, float hi) { return f2bf(lo) | (f2bf(hi) << 16); }
__device__ __forceinline__ void tr_item(const float* __restrict__ W, int K, int N, const float* __restrict__ gain, bf16_t* WT, int nblk2  , int mode, LAS bf16_t* scr, int item, int lane) {
    const int kb = item / nblk2, nb2 = item - kb * nblk2, k0 = 64 * kb;
    const int blk = (lane >> 3) & 1, n4 = (lane & 7) * 4, kr0 = lane >> 4;
    const int sc = srccol(mode, 2 * nb2 + blk);
    f32x4 v[16];
    const float* src = W + (size_t)(k0 + kr0) * N + (sc >= 0 ? sc : 0) + n4;
#pragma unroll
    for (int i = 0; i < 16; ++i) v[i] = __builtin_nontemporal_load((const f32x4*)(src + (size_t)(4 * i) * N));
    if (gain) {
#pragma unroll
        for (int i = 0; i < 16; ++i) v[i] = v[i] * gain[k0 + kr0 + 4 * i];
    }
    if (sc < 0) {
#pragma unroll
        for (int i = 0; i < 16; ++i) v[i] = (f32x4){0.f, 0.f, 0.f, 0.f};
    }
    LAS bf16_t* d = scr + (32 * blk + n4) * 66 + kr0;
#pragma unroll
    for (int i = 0; i < 16; ++i) {
        const unsigned p01 = cvt_pk_bf16(v[i][0], v[i][1]), p23 = cvt_pk_bf16(v[i][2], v[i][3]);
        d[0 * 66 + 4 * i] = (bf16_t)(p01 & 0xffffu); d[1 * 66 + 4 * i] = (bf16_t)(p01 >> 16);
        d[2 * 66 + 4 * i] = (bf16_t)(p23 & 0xffffu); d[3 * 66 + 4 * i] = (bf16_t)(p23 >> 16);
    }
    asm volatile("s_waitcnt lgkmcnt(0)" ::: "memory");
    const int c = lane & 7;
#pragma unroll
    for (int j = 0; j < 8; ++j) { const int n = (lane >> 3) + 8 * j; const LAS unsigned* sp = (const LAS unsigned*)(scr + n * 66 + 8 * c);
        u32x4 o; o.x = sp[0]; o.y = sp[1]; o.z = sp[2]; o.w = sp[3];
        *(u32x4*)(WT + (size_t)(64 * nb2 + n) * K + k0 + 8 * c) = o; }
    asm volatile("s_waitcnt lgkmcnt(0)" ::: "memory");
}
template <int MODE>
__device__ __forceinline__ void row_phase(const float* x32, bf16_t* xb, const bf16_t* f, const float* g, float c, float* rstd, float* out32) {
    const int tid = otid(), lane = tid & 63, gw = blockIdx.x * 8 + __builtin_amdgcn_readfirstlane(tid >> 6), ngw = gridDim.x * 8;
    for (int m = gw; m < M_TOK; m += ngw) {
        float xv[4][8];
        const size_t ro = (size_t)m * DM + 8 * lane;
        if (MODE == 0) {
#pragma unroll
            for (int j = 0; j < 4; ++j) { const f32x4 a = __builtin_nontemporal_load((const f32x4*)(x32 + ro + 512 * j)), b = __builtin_nontemporal_load((const f32x4*)(x32 + ro + 512 * j + 4));
#pragma unroll
                for (int e = 0; e < 4; ++e) { xv[j][e] = a[e]; xv[j][4 + e] = b[e]; } }
        } else {
            u32x4 xr[4], fr_[4];
#pragma unroll
            for (int j = 0; j < 4; ++j) { xr[j] = *(const u32x4*)(xb + ro + 512 * j); fr_[j] = *(const u32x4*)(f + ro + 512 * j); }
            float fv[4][8]; float s = 0.f;
#pragma unroll
            for (int j = 0; j < 4; ++j)
#pragma unroll
                for (int q = 0; q < 4; ++q) { const unsigned fu = fr_[j][q], xu = xr[j][q];
                    fv[j][2 * q] = __uint_as_float(fu << 16); fv[j][2 * q + 1] = __uint_as_float(fu & 0xffff0000u);
                    xv[j][2 * q] = __uint_as_float(xu << 16); xv[j][2 * q + 1] = __uint_as_float(xu & 0xffff0000u);
                    s += fv[j][2 * q] * fv[j][2 * q] + fv[j][2 * q + 1] * fv[j][2 * q + 1]; }
            s = wave_sum(s); const float rs = rsqrtf(s * (1.0f / DM) + EPS) * c;
#pragma unroll
            for (int j = 0; j < 4; ++j) { const f32x4 g0 = *(const f32x4*)(g + 8 * lane + 512 * j), g1 = *(const f32x4*)(g + 8 * lane + 512 * j + 4);
#pragma unroll
                for (int e = 0; e < 4; ++e) { xv[j][e] += fv[j][e] * g0[e] * rs; xv[j][4 + e] += fv[j][4 + e] * g1[e] * rs; } }
        }
        if (MODE == 2) {
#pragma unroll
            for (int j = 0; j < 4; ++j) { *(f32x4*)(out32 + ro + 512 * j) = (f32x4){xv[j][0], xv[j][1], xv[j][2], xv[j][3]}; *(f32x4*)(out32 + ro + 512 * j + 4) = (f32x4){xv[j][4], xv[j][5], xv[j][6], xv[j][7]}; }
        } else {
            float s2 = 0.f;
#pragma unroll
            for (int j = 0; j < 4; ++j)
#pragma unroll
                for (int e = 0; e < 8; ++e) s2 += xv[j][e] * xv[j][e];
            s2 = wave_sum(s2);
            if (lane == 0) rstd[m] = rsqrtf(s2 * (1.0f / DM) + EPS);
#pragma unroll
            for (int j = 0; j < 4; ++j) { u32x4 w; w.x = cvt_pk_bf16(xv[j][0], xv[j][1]); w.y = cvt_pk_bf16(xv[j][2], xv[j][3]); w.z = cvt_pk_bf16(xv[j][4], xv[j][5]); w.w = cvt_pk_bf16(xv[j][6], xv[j][7]);
                *(u32x4*)(xb + ro + 512 * j) = w; }
        }
    }
}
__device__ __forceinline__ float bf2f(bf16_t v) { return __uint_as_float((unsigned)v << 16); }
__device__ __forceinline__ void conv_phase(LAS unsigned char* lds, const bf16_t* glu, const float* wdw, const float* bdw, const float* gln, const float* bln, bf16_t* cv, int blk, int nblk) {
    const int tid = otid();
    LAS bf16_t* gs = (LAS bf16_t*)lds;
    LAS float* ys = (LAS float*)(lds + 64 * 1024);
    LAS float* stat = (LAS float*)(lds + 48 * 1024 + 1024);
    const int c = tid;
    float w[31];
#pragma unroll
    for (int i = 0; i < 31; ++i) w[i] = wdw[i * 512 + c];
    const float bd = bdw[c], gl = gln[c], bl = bln[c];
    const bool bal = (nblk == 256); const int nu = bal ? (blk < 128 ? 3 : 5) : (M_TOK / 16 - blk + nblk - 1) / nblk;
    for (int ui = 0; ui < nu; ++ui) {
        const int unit = bal ? (blk < 128 ? blk + 128 * ui : 384 + (blk - 128) + 128 * ui) : blk + ui * nblk;
        const int tok0 = unit * 16, t0 = tok0 & (SEQ - 1);
        for (int idx = tid; idx < 46 * 64; idx += 512) { const int row = idx >> 6, ch = idx & 63; u32x4 v = (u32x4){0u, 0u, 0u, 0u};
            if (t0 - 30 + row >= 0) v = *(const u32x4*)(glu + (size_t)(tok0 - 30 + row) * 512 + ch * 8);
            *(LAS u32x4*)(gs + row * 512 + ch * 8) = v; }
        __syncthreads();
        float y[16];
#pragma unroll
        for (int t = 0; t < 16; ++t) y[t] = bd;
#pragma unroll
        for (int rr = 0; rr < 46; ++rr) { const float gval = bf2f(gs[rr * 512 + c]);
#pragma unroll
            for (int t = 0; t < 16; ++t) { if (rr - t >= 0 && rr - t <= 30) y[t] += gval * w[rr - t]; } }
#pragma unroll
        for (int t = 0; t < 16; ++t) ys[t * 512 + c] = y[t];
        __syncthreads();
        { const int t2 = tid >> 5, p = tid & 31; float sm = 0.f, sq = 0.f;
#pragma unroll
          for (int i = 0; i < 16; ++i) { const float v = ys[t2 * 512 + p + 32 * i]; sm += v; sq += v * v; }
#pragma unroll
          for (int o = 1; o < 32; o <<= 1) { sm += __shfl_xor(sm, o); sq += __shfl_xor(sq, o); }
          if (p == 0) { const float mean = sm * (1.0f / 512.0f), var = fmaxf(sq * (1.0f / 512.0f) - mean * mean, 0.f); stat[t2 * 2] = mean; stat[t2 * 2 + 1] = rsqrtf(var + EPS); } }
        __syncthreads();
#pragma unroll
        for (int t = 0; t < 16; ++t) { const float v = (y[t] - stat[t * 2]) * stat[t * 2 + 1] * gl + bl; cv[(size_t)(tok0 + t) * 512 + c] = (bf16_t)f2bf(v * sigmoidf_(v)); }
        __syncthreads();
    }
}

#define XB_TMO      128
#define XB_XCNT(j)  (256  + 64 * (j))
#define XB_XSUB(j)  (1280 + 64 * (j))
#define XB_XGEN(j)  (2304 + 64 * (j))
#define XB_TOP      3328
#define XB_TOPGEN   3392
#define XCD_BAR_WORDS 3456
#define XB_SPIN_CAP (1u << 18)

__device__ __forceinline__ unsigned xb_ld(unsigned* p)              { return __hip_atomic_load(p, __ATOMIC_RELAXED, __HIP_MEMORY_SCOPE_AGENT); }
__device__ __forceinline__ unsigned xb_add(unsigned* p, unsigned v) { return __hip_atomic_fetch_add(p, v, __ATOMIC_RELAXED, __HIP_MEMORY_SCOPE_AGENT); }
__device__ __forceinline__ unsigned xb_xcc_id() { return (unsigned)__builtin_amdgcn_s_getreg((3 << 11) | 20) & 0xFu; }
#define XB_SPIN(cond, bar) do { unsigned _sp = 0; while (cond) { __builtin_amdgcn_s_sleep(1); \
    if ((++_sp & 255u) == 0u) { if (xb_ld(&(bar)[XB_TMO])) break; if (_sp > XB_SPIN_CAP) { atomicAdd(&(bar)[XB_TMO], 1u); break; } } } } while (0)

struct XcdBarrier {
    unsigned* bar; unsigned x;
    volatile LAS unsigned* st;
};

__device__ __forceinline__ XcdBarrier xcd_barrier_post(unsigned* bar, volatile LAS unsigned* st) {
    XcdBarrier b; b.bar = bar; b.x = xb_xcc_id(); b.st = st;
    if (threadIdx.x == 0) (void)xb_add(&bar[XB_XCNT(b.x)], 1u);
    return b;
}
__device__ __forceinline__ void xcd_barrier_complete(unsigned* bar, unsigned x, unsigned& nloc, unsigned& nx) {
    const unsigned G = gridDim.x * gridDim.y * gridDim.z;
    unsigned sum, cnt, mine, sp = 0u;
    for (;;) {
        sum = 0u; cnt = 0u; mine = 0u;
#pragma unroll
        for (unsigned j = 0; j < 16; ++j) { const unsigned c = xb_ld(&bar[XB_XCNT(j)]); sum += c; cnt += (c > 0u) ? 1u : 0u; mine = (j == x) ? c : mine; }
        if (sum == G) break;
        __builtin_amdgcn_s_sleep(1);
        if ((++sp & 255u) == 0u) { if (xb_ld(&bar[XB_TMO])) break; if (sp > XB_SPIN_CAP) { atomicAdd(&bar[XB_TMO], 1u); break; } }
    }
    nloc = mine > 0u ? mine : 1u; nx = cnt > 0u ? cnt : 1u;
}

__device__ __forceinline__ void xcd_barrier(const XcdBarrier& b) {
    asm volatile("s_waitcnt vmcnt(0)" ::: "memory");
    __syncthreads();
    if (threadIdx.x == 0) {
        unsigned* bar = b.bar;
        __builtin_amdgcn_s_waitcnt(0);
        unsigned nloc = b.st[0], nx = b.st[1];
        if (nloc == 0u) { xcd_barrier_complete(bar, b.x, nloc, nx); b.st[0] = nloc; b.st[1] = nx; }
        const unsigned old = xb_add(&bar[XB_XSUB(b.x)], 1u);
        const unsigned gen = old / nloc;
        if (old + 1u == (gen + 1u) * nloc) {
            __builtin_amdgcn_fence(__ATOMIC_RELEASE, "agent");
            asm volatile("s_waitcnt vmcnt(0)" ::: "memory");
            const unsigned og = xb_add(&bar[XB_TOP], 1u);
            const unsigned tg = og / nx;
            if (og + 1u == (tg + 1u) * nx) xb_add(&bar[XB_TOPGEN], 1u);
            else XB_SPIN(xb_ld(&bar[XB_TOPGEN]) == tg, bar);
            __builtin_amdgcn_fence(__ATOMIC_ACQUIRE, "agent");
            xb_add(&bar[XB_XGEN(b.x)], 1u);
            asm volatile("s_waitcnt vmcnt(0)" ::: "memory");
        } else {
            XB_SPIN(xb_ld(&bar[XB_XGEN(b.x)]) == gen, bar);
            __builtin_amdgcn_fence(__ATOMIC_ACQUIRE, "agent");
            asm volatile("s_waitcnt vmcnt(0)" ::: "memory");
        }
    }
    __syncthreads();
}

#ifndef PHMASK
#define PHMASK 0xffff
#endif
#define PH_ON(k) (((PHMASK) >> (k)) & 1)
#ifndef REP_P0
#define REP_P0 1
#endif
#ifndef REP_FFN
#define REP_FFN 1
#endif
#ifndef REP_ATT
#define REP_ATT 1
#endif
#ifndef REP_ROW
#define REP_ROW 1
#endif
struct Params { const float* in[28]; float* out; unsigned char* ws; };
static_assert(sizeof(Params) == 30 * 8, "no padding");
typedef pg8::StaticOrder SO;
#define GEMM_RUN(EPI_T, epi, Aptr, Bptr, Nn, Kk) GEMM_RUN_G(EPI_T, epi, Aptr, Bptr, Nn, Kk, G, bx)
#define GEMM_RUN_G(EPI_T, epi, Aptr, Bptr, Nn, Kk, GG, CC) do { int kk_ = (Kk); asm volatile("" : "+s"(kk_));     \
        pg8::Gemm g_{(const bf16_t*)(Aptr), (const bf16_t*)(Bptr), M_TOK, (Nn), kk_}; SO S_; S_.init(M_TOK, (Nn), (GG), (CC)); \
        pg8::gemm_phase<EPI_T, SO, true, true>(lds, g_, S_, (epi)); } while (0)

__device__ __forceinline__ unsigned char* ows(unsigned char* p) { __attribute__((address_space(1))) unsigned char* g = (__attribute__((address_space(1))) unsigned char*)p; asm volatile("" : "+s"(g)); return (unsigned char*)g; }
#define BF(off) ((bf16_t*)(wsp + (off)))
#define FP(off) ((float*)(wsp + (off)))
__global__ void __launch_bounds__(512) mega_fwd(Params P) {
    extern __shared__ __attribute__((aligned(16))) unsigned char lds_raw[];
    LAS unsigned char* lds = (LAS unsigned char*)lds_raw;
    cg::grid_group grid = cg::this_grid();
    const int G = gridDim.x, bx = blockIdx.x;
    if (threadIdx.x < 64) ((LAS unsigned*)(lds + MISC_OFF))[threadIdx.x] = 0u;
    __syncthreads();
    const XcdBarrier bar = xcd_barrier_post((unsigned*)P.ws + CW_BAR, (volatile LAS unsigned*)(lds + MISC_OFF + 64));
    if (P.ws == nullptr) grid.sync();
#define SEAM() do { XcdBarrier b_ = bar; asm volatile("" : "+s"(b_.bar), "+s"(b_.x)); xcd_barrier(b_); } while (0)

    for (int rep0 = 0; rep0 < REP_P0; ++rep0) {
        unsigned char* wsp = ows(P.ws);
        const int tid = otid(), lane = tid & 63, wid = __builtin_amdgcn_readfirstlane(tid >> 6), gw = bx * 8 + wid, ngw = G * 8;
        LAS bf16_t* scr = (LAS bf16_t*)(lds + wid * 16384);
        constexpr int I1 = 5632, I2 = 2816, I3 = 1792, I4 = 192, I5 = 128, I6 = 64, I7 = 1024, I10 = 1024, I11 = 128;
        constexpr int IL = I1 + I2 + I3 + I4 + I5 + I6 + I7 + I1 + I2 + I10 + I11;
        for (int it = gw; it < 2 * IL; it += ngw) {
            const int L = it >= IL ? 1 : 0; int r = it - L * IL;
            unsigned char* wl = wsp + WS_W + (size_t)L * W_LAYER;
            if (r < I1) { tr_item(P.in[4] + (size_t)L * DM * 2 * DFF, DM, 2 * DFF, P.in[3] + L * DM, (bf16_t*)(wl + WO_FF1IN), 176, 1, scr, r, lane); continue; } r -= I1;
            if (r < I2) { tr_item(P.in[5] + (size_t)L * DFF * DM, DFF, DM, nullptr, (bf16_t*)(wl + WO_FF1OUT), 32, 0, scr, r, lane); continue; } r -= I2;
            if (r < I3) { tr_item(P.in[8] + (size_t)L * DM * 3392, DM, 3392, P.in[7] + L * DM, (bf16_t*)(wl + WO_IN), 56, 2, scr, r, lane); continue; } r -= I3;
            if (r < I4) { tr_item(P.in[10] + (size_t)L * 512 * 1536, 512, 1536, P.in[9] + L * 512, (bf16_t*)(wl + WO_UQ), 24, 3, scr, r, lane); continue; } r -= I4;
            if (r < I5) { tr_item(P.in[12] + (size_t)L * 256 * 2048, 256, 2048, P.in[11] + L * 256, (bf16_t*)(wl + WO_UKV), 32, 0, scr, r, lane); continue; } r -= I5;
            if (r < I6) { tr_item(P.in[17] + (size_t)L * 512 * 512, 512, 512, nullptr, (bf16_t*)(wl + WO_PW), 8, 0, scr, r, lane); continue; } r -= I6;
            if (r < I7) { tr_item(P.in[18] + (size_t)L * DM * DM, DM, DM, nullptr, (bf16_t*)(wl + WO_OUT), 32, 0, scr, r, lane); continue; } r -= I7;
            if (r < I1) { tr_item(P.in[21] + (size_t)L * DM * 2 * DFF, DM, 2 * DFF, P.in[20] + L * DM, (bf16_t*)(wl + WO_FF2IN), 176, 1, scr, r, lane); continue; } r -= I1;
            if (r < I2) { tr_item(P.in[22] + (size_t)L * DFF * DM, DFF, DM, nullptr, (bf16_t*)(wl + WO_FF2OUT), 32, 0, scr, r, lane); continue; } r -= I2;
            if (r < I10) { tr_item(P.in[25] + (size_t)L * DM * DM, DM, DM, P.in[24] + L * DM, (bf16_t*)(wl + WO_GATE), 32, 0, scr, r, lane); continue; } r -= I10;
            tr_item(P.in[26] + (size_t)L * 256 * DM, 256, DM, nullptr, (bf16_t*)(wl + WO_PROJ), 32, 0, scr, r, lane);
        }
        const int gt = bx * 512 + tid, ngt = G * 512;
        for (int i = gt; i < 2 * M_TOK * 256 / 4; i += ngt) { const f32x4 v = ((const f32x4*)P.in[1])[i]; u32x2 w; w.x = cvt_pk_bf16(v[0], v[1]); w.y = cvt_pk_bf16(v[2], v[3]); ((u32x2*)BF(WS_PB))[i] = w; }
        const int* pos = (const int*)P.in[2];
        for (int i = gt; i < M_TOK * 32; i += ngt) { const int tok = i >> 5, j = i & 31;
            const float inv = exp2f(-(float)j * (13.287712379549449f / 32.0f));
            const float ang = (float)pos[tok] * inv;
            double rev = (double)ang * 0.15915494309189535; rev -= floor(rev);
            FP(WS_COS)[i] = __builtin_amdgcn_cosf((float)rev); FP(WS_SIN)[i] = __builtin_amdgcn_sinf((float)rev); }
        row_phase<0>(P.in[0], BF(WS_XN), nullptr, nullptr, 0.f, FP(WS_RSTD), nullptr);
    }
    SEAM();

    for (int L = 0; L < 2; ++L) {
        for (int rf = 0; rf < REP_FFN; ++rf) { unsigned char* wsp = ows(P.ws); unsigned char* wl = wsp + WS_W + (size_t)L * W_LAYER; EpiSwiglu E{BF(WS_HID), FP(WS_RSTD)}; GEMM_RUN(EpiSwiglu, E, BF(WS_XN), wl + WO_FF1IN, 2 * DFF, DM); }
        SEAM();
        for (int rf = 0; rf < REP_FFN; ++rf) { unsigned char* wsp = ows(P.ws); unsigned char* wl = wsp + WS_W + (size_t)L * W_LAYER; EpiBf E{BF(WS_F), DM}; GEMM_RUN(EpiBf, E, BF(WS_HID), wl + WO_FF1OUT, DM, DFF); }
        SEAM();
        if (PH_ON(3)) { unsigned char* wsp = ows(P.ws); row_phase<1>(nullptr, BF(WS_XN), BF(WS_F), P.in[6] + L * DM, 0.5f, FP(WS_RSTD), nullptr); }
        SEAM();
        if (PH_ON(4)) { unsigned char* wsp = ows(P.ws); unsigned char* wl = wsp + WS_W + (size_t)L * W_LAYER; EpiWin E{wsp}; GEMM_RUN(EpiWin, E, BF(WS_XN), wl + WO_IN, NWIN, DM);
            if (PH_ON(11) && G == 256 && bx >= 128) { EpiBf E2{BF(WS_EB), DM}; GEMM_RUN_G(EpiBf, E2, BF(WS_PB) + (size_t)L * M_TOK * 256, wl + WO_PROJ, DM, 256, 128, bx - 128); } }
        SEAM();
        if (PH_ON(5)) { unsigned char* wsp = ows(P.ws); conv_phase(lds, BF(WS_GLU), P.in[13] + L * 31 * 512, P.in[14] + L * 512, P.in[15] + L * 512, P.in[16] + L * 512, BF(WS_CV), bx, G); }
        if (PH_ON(6)) { unsigned char* wsp = ows(P.ws); unsigned char* wl = wsp + WS_W + (size_t)L * W_LAYER; EpiUq E{BF(WS_Q), FP(WS_SSQ), FP(WS_COS), FP(WS_SIN)}; GEMM_RUN(EpiUq, E, BF(WS_CQ), wl + WO_UQ, 1536, 512); }
        if (PH_ON(7)) { unsigned char* wsp = ows(P.ws); unsigned char* wl = wsp + WS_W + (size_t)L * W_LAYER; EpiUkv E{BF(WS_KN), BF(WS_V), FP(WS_SSQ)}; GEMM_RUN(EpiUkv, E, BF(WS_CKV), wl + WO_UKV, 2048, 256); }
        SEAM();
        if (PH_ON(8)) { unsigned char* wsp = ows(P.ws); unsigned char* wl = wsp + WS_W + (size_t)L * W_LAYER; EpiBf E{BF(WS_MIX) + 1024, DM}; GEMM_RUN(EpiBf, E, BF(WS_CV), wl + WO_PW, 512, 512); }
        if (PH_ON(9) || PH_ON(10)) {
            unsigned char* wsp = ows(P.ws);
            LAS int* slot = (LAS int*)(lds + MISC_OFF);
            const int tid = otid();
            for (;;) {
                __syncthreads();
                const int nq = G == 256 ? 96 : 768;
                if (tid == 0) {
                    int xs = G == 256 ? (bx & 7) : 0, got = -1;
                    for (int k = 0; k < (G == 256 ? 8 : 1); ++k) {
                        const int i_ = (int)atomicAdd((unsigned*)wsp + 64 * (L * 8 + xs), 1u);
                        if (i_ < nq) { got = i_; break; }
                        xs = (xs + 1) & 7;
                    }
                    slot[0] = got; slot[1] = xs;
                }
                __syncthreads();
                const int it = __builtin_amdgcn_readfirstlane(slot[0]), xq = __builtin_amdgcn_readfirstlane(slot[1]);
                if (it < 0) break;
                int qblk, r; bool sb;
                if (G == 256) { const int lvl = it / 6; r = it - lvl * 6; qblk = 15 - lvl; sb = r < 2; r = sb ? 2 * xq + r : 4 * xq + (r - 2); }
                else { const int lvl = it / 48; r = it - lvl * 48; qblk = 15 - lvl; sb = r < 16; r = sb ? r : r - 16; }
                const bool prb = false;
                if (sb) { if (PH_ON(9)) { const int b = r >> 2, h = r & 3;
                    att::attn_unit<true>(lds, BF(WS_SBQ) + h * 128, 512, BF(WS_SBK) + h * 128, 512, BF(WS_SBV) + h * 128, 512, nullptr, BF(WS_MIX) + 1536 + h * 128, b * SEQ, qblk); }
                } else if (PH_ON(10)) { const int b = r >> 3, h = r & 7;
                    att::attn_unit<false>(lds, BF(WS_Q) + h * 192, 1536, BF(WS_KN) + h * 128, 1024, BF(WS_V) + h * 128, 1024, BF(WS_KR), BF(WS_MIX) + h * 128, b * SEQ, qblk); }
            }
        }
        SEAM();
        if (PH_ON(2)) { unsigned char* wsp = ows(P.ws); unsigned char* wl = wsp + WS_W + (size_t)L * W_LAYER; EpiBf E{BF(WS_F), DM}; GEMM_RUN(EpiBf, E, BF(WS_MIX), wl + WO_OUT, DM, DM); }
        SEAM();
        if (PH_ON(3)) { unsigned char* wsp = ows(P.ws); row_phase<1>(nullptr, BF(WS_XN), BF(WS_F), P.in[19] + L * DM, 1.0f, FP(WS_RSTD), nullptr); }
        SEAM();
        for (int rf = 0; rf < REP_FFN; ++rf) { unsigned char* wsp = ows(P.ws); unsigned char* wl = wsp + WS_W + (size_t)L * W_LAYER; EpiSwiglu E{BF(WS_HID), FP(WS_RSTD)}; GEMM_RUN(EpiSwiglu, E, BF(WS_XN), wl + WO_FF2IN, 2 * DFF, DM); }
        SEAM();
        for (int rf = 0; rf < REP_FFN; ++rf) { unsigned char* wsp = ows(P.ws); unsigned char* wl = wsp + WS_W + (size_t)L * W_LAYER; EpiBf E{BF(WS_F), DM}; GEMM_RUN(EpiBf, E, BF(WS_HID), wl + WO_FF2OUT, DM, DFF); }
        SEAM();
        if (PH_ON(3)) { unsigned char* wsp = ows(P.ws); row_phase<1>(nullptr, BF(WS_XN), BF(WS_F), P.in[23] + L * DM, 0.5f, FP(WS_RSTD), nullptr); }
        SEAM();
        if (PH_ON(11) && G != 256) { unsigned char* wsp = ows(P.ws); unsigned char* wl = wsp + WS_W + (size_t)L * W_LAYER; EpiBf E{BF(WS_EB), DM}; GEMM_RUN(EpiBf, E, BF(WS_PB) + (size_t)L * M_TOK * 256, wl + WO_PROJ, DM, 256); SEAM(); }
        if (PH_ON(12)) { unsigned char* wsp = ows(P.ws); unsigned char* wl = wsp + WS_W + (size_t)L * W_LAYER; EpiGate E{BF(WS_F), BF(WS_EB), FP(WS_RSTD)}; GEMM_RUN(EpiGate, E, BF(WS_XN), wl + WO_GATE, DM, DM); }
        SEAM();
        if (PH_ON(3)) { unsigned char* wsp = ows(P.ws);
            if (L == 0) row_phase<1>(nullptr, BF(WS_XN), BF(WS_F), P.in[27] + L * DM, 1.0f, FP(WS_RSTD), nullptr);
            else row_phase<2>(nullptr, BF(WS_XN), BF(WS_F), P.in[27] + L * DM, 1.0f, nullptr, P.out); }
        if (L == 0) SEAM();
    }
}

extern "C" void kernel_launch(void* const* d_in, const int* in_sizes, int n_in, void* d_out, int out_size, void* d_ws, size_t ws_size, hipStream_t stream) {
    static int grid = 0;
    if (grid == 0) {
        if (n_in != 28 || out_size != M_TOK * DM || ws_size < WS_END) { fprintf(stderr, "kernel_launch: unexpected shapes (n_in %d out %d ws %zu)\n", n_in, out_size, ws_size); grid = -1; return; }
        int dev = 0, cus = 0, per_cu = 0;
        (void)hipGetDevice(&dev); (void)hipDeviceGetAttribute(&cus, hipDeviceAttributeMultiprocessorCount, dev);
        if (hipFuncSetAttribute((const void*)mega_fwd, hipFuncAttributeMaxDynamicSharedMemorySize, LDS_BYTES) != hipSuccess) { fprintf(stderr, "kernel_launch: hipFuncSetAttribute failed\n"); grid = -1; return; }
        if (hipOccupancyMaxActiveBlocksPerMultiprocessor(&per_cu, (const void*)mega_fwd, 512, LDS_BYTES) != hipSuccess || per_cu < 1) { fprintf(stderr, "kernel_launch: occupancy query says %d\n", per_cu); per_cu = 1; }
        (void)hipGetLastError();
        grid = cus * 1;
    }
    if (grid < 0) return;
    if (hipMemsetAsync(d_ws, 0, 65536, stream) != hipSuccess) { fprintf(stderr, "kernel_launch: memset of the control words failed\n"); return; }
    Params p{};
    for (int i = 0; i < 28; ++i) p.in[i] = (const float*)d_in[i];
    p.out = (float*)d_out; p.ws = (unsigned char*)d_ws;
    void* args[] = {&p};
    hipError_t e = hipLaunchCooperativeKernel((const void*)mega_fwd, dim3(grid), dim3(512), args, LDS_BYTES, stream);
    if (e != hipSuccess) fprintf(stderr, "cooperative launch failed: %s (grid %d)\n", hipGetErrorString(e), grid);
}
```

```cpp
#include <hip/hip_runtime.h>
#include <hip/hip_cooperative_groups.h>
#include <cstdio>
#include <cstdint>
namespace cg = cooperative_groups;
namespace pg8 {
#define PG8_LAS __attribute__((address_space(3)))
typedef unsigned short bf16_t;
typedef short bf16x8 __attribute__((ext_vector_type(8)));
typedef float f32x4 __attribute__((ext_vector_type(4)));
typedef unsigned u32x4 __attribute__((ext_vector_type(4)));
constexpr int BM = 256, BK = 64, HALF = 128, HTB = HALF * BK * 2  , STAGE_BYTES = 8 * HTB, NXCD = 8, WGM = 4;

__host__ __device__ __forceinline__ int lds_byte(int r, int c) { const int st = (r >> 4) * 2 + (c >> 5), rr = r & 15, cc = c & 31, ob = rr * 64 + cc * 2; return st * 1024 + (ob ^ (((ob >> 9) & 1) << 5)); }
__host__ __device__ __forceinline__ void stage_rc(int b, int& R, int& C) { const int st = b / 1024, sb = b % 1024, swz = sb ^ (((sb >> 9) & 1) << 5); R = (st >> 1) * 16 + swz / 64; C = (st & 1) * 32 + (swz % 64) / 2; }
__host__ __device__ __forceinline__ int perm32(int rho) { const int n = rho >> 4, i = rho & 15; return 8 * (i >> 2) + 4 * n + (i & 3); }

struct Unit { int pm, pn; };
struct Gemm { const bf16_t* A; const bf16_t* Bt; int M, N, K; };

struct StaticOrder {
    int nM, nN, nwg, G, c;
    __host__ __device__ void init(int M, int N, int G_, int c_) { nM = M / BM; nN = N / BM; nwg = nM * nN; G = G_; c = c_; }
    __host__ __device__ bool next(int i, Unit& u) const {
        const long L = (long)i * G + c; if (L >= nwg) return false;
        int wgid = (int)L; { const int q = nwg / NXCD, r = nwg % NXCD, xcd = wgid % NXCD, off = wgid / NXCD; wgid = (xcd < r ? xcd * (q + 1) : r * (q + 1) + (xcd - r) * q) + off; }
        const int nig = WGM * nN, gid = wgid / nig, fm = gid * WGM, gsz = (nM - fm) < WGM ? (nM - fm) : WGM;
        u.pm = fm + ((wgid % nig) % gsz); u.pn = (wgid % nig) / gsz; return true;
    }
    __device__ __forceinline__ void a_ready(const Unit&) const {}
    __device__ __forceinline__ void done(const Unit&) const {}
};
__device__ __forceinline__ unsigned cvt_pk_bf16(float lo, float hi) { unsigned r; asm volatile("v_cvt_pk_bf16_f32 %0, %1, %2" : "=v"(r) : "v"(lo), "v"(hi)); return r; }
typedef float f32x2 __attribute__((ext_vector_type(2)));
template <class Epi, class Sched, bool ALIGN_EPI = false, bool SP2 = false>
__device__ __forceinline__ void gemm_phase(PG8_LAS unsigned char* lds, const Gemm g, const Sched& S, const Epi& E) {
    int tid_o = threadIdx.x; asm volatile("" : "+v"(tid_o));
    const int tid = tid_o, wid = __builtin_amdgcn_readfirstlane(tid >> 6), lane = tid & 63, wr = wid >> 2, wc = wid & 3, fr = lane & 15, fq = lane >> 4;
    const int K = g.K, nt = K / BK;
    unsigned voffA[2], voffB[2];
#pragma unroll
    for (int i = 0; i < 2; ++i) { int R, C; stage_rc(tid * 16 + i * 8192, R, C); const int Rb = Epi::PERM ? ((R & ~31) + perm32(R & 31)) : R;
        voffA[i] = (unsigned)(R * K + C) * 2u; voffB[i] = (unsigned)(Rb * K + C) * 2u; }
    const size_t kstep = (size_t)(BK * 2);
    const size_t hstep = (size_t)HALF * K * 2;
    const size_t tstep = 2 * hstep;
    const unsigned ldsw = (unsigned)wid * 1024u;
    const int aoff = lds_byte(wr * 64 + fr, fq * 8), boff = lds_byte(wc * 32 + fr, fq * 8);
#define PG8_SA(b, h) (((b) * 2 + (h)) * HTB)
#define PG8_SB(b, h) ((4 + (b) * 2 + (h)) * HTB)
#define PG8_STAGE(bufoff, gbase, voff) do { _Pragma("unroll") for (int _i = 0; _i < 2; ++_i) \
        __builtin_amdgcn_global_load_lds((const unsigned*)((const char*)(gbase) + (voff)[_i]), (PG8_LAS unsigned*)(lds + (bufoff) + ldsw + _i * 8192), 16, 0, 0); } while (0)
#define PG8_LDA(dst, b, h) do { _Pragma("unroll") for (int m = 0; m < 4; ++m) _Pragma("unroll") for (int k = 0; k < 2; ++k) dst[m][k] = *(const PG8_LAS bf16x8*)(lds + PG8_SA(b, h) + aoff + m * 2048 + k * 1024); } while (0)
#define PG8_LDB(dst, b, h) do { _Pragma("unroll") for (int n = 0; n < 2; ++n) _Pragma("unroll") for (int k = 0; k < 2; ++k) dst[n][k] = *(const PG8_LAS bf16x8*)(lds + PG8_SB(b, h) + boff + n * 2048 + k * 1024); } while (0)
#define PG8_MMA(ai, bj, At, Bt) do { __builtin_amdgcn_s_setprio(1); _Pragma("unroll") for (int m = 0; m < 4; ++m) _Pragma("unroll") for (int n = 0; n < 2; ++n) _Pragma("unroll") for (int k = 0; k < 2; ++k) \
        acc[ai][bj][m][n] = __builtin_amdgcn_mfma_f32_16x16x32_bf16(Bt[n][k], At[m][k], acc[ai][bj][m][n], 0, 0, 0); __builtin_amdgcn_s_setprio(0); } while (0)
#define PG8_WAIT_V(n) asm volatile("s_waitcnt vmcnt(" #n ")" ::: "memory")
#define PG8_WAIT_L(n) asm volatile("s_waitcnt lgkmcnt(" #n ")" ::: "memory")
#define PG8_BAR __builtin_amdgcn_s_barrier()
#define PG8_SCHED __builtin_amdgcn_sched_barrier(0)
    Unit cur, nxt; int ui = 0;
    if (!S.next(0, cur)) return;
    f32x4 acc[2][2][4][2];
#pragma unroll
    for (int a = 0; a < 2; ++a)
#pragma unroll
        for (int b = 0; b < 2; ++b)
#pragma unroll
            for (int m = 0; m < 4; ++m)
#pragma unroll
                for (int n = 0; n < 2; ++n) acc[a][b][m][n] = (f32x4){0.f, 0.f, 0.f, 0.f};
    bf16x8 At[4][2], B0[2][2], B1[2][2];
    const char* cA = (const char*)g.A + (size_t)cur.pm * tstep; const char* cB = (const char*)g.Bt + (size_t)cur.pn * tstep;
    S.a_ready(cur);
    if constexpr (SP2) {
        PG8_STAGE(PG8_SB(0, 0), cB, voffB); PG8_STAGE(PG8_SB(0, 1), cB + hstep, voffB); PG8_STAGE(PG8_SA(0, 0), cA, voffA); PG8_STAGE(PG8_SA(0, 1), cA + hstep, voffA);
        if (wr == 1) PG8_BAR;
        PG8_WAIT_V(2); PG8_BAR;
        PG8_STAGE(PG8_SB(1, 0), cB + kstep, voffB); PG8_STAGE(PG8_SA(1, 0), cA + kstep, voffA); PG8_STAGE(PG8_SB(1, 1), cB + hstep + kstep, voffB);
        PG8_WAIT_V(6); PG8_BAR;
    } else {
        PG8_STAGE(PG8_SB(0, 0), cB, voffB); PG8_STAGE(PG8_SA(0, 0), cA, voffA); PG8_STAGE(PG8_SB(0, 1), cB + hstep, voffB); PG8_STAGE(PG8_SA(0, 1), cA + hstep, voffA);
        if (wr == 1) PG8_BAR;
        PG8_WAIT_V(4); PG8_BAR;
        PG8_STAGE(PG8_SB(1, 0), cB + kstep, voffB); PG8_STAGE(PG8_SA(1, 0), cA + kstep, voffA); PG8_STAGE(PG8_SB(1, 1), cB + hstep + kstep, voffB);
        PG8_WAIT_V(6); PG8_BAR;
    }
    for (;;) {
        const bool has_next = S.next(ui + 1, nxt);
        const char* nA = has_next ? (const char*)g.A + (size_t)nxt.pm * tstep : cA; const char* nB = has_next ? (const char*)g.Bt + (size_t)nxt.pn * tstep : cB;
        for (int t = 0; t < nt; t += 2) {
            const bool last = (t == nt - 2);
            const char* a1 = cA + (size_t)(t + 1) * kstep;
            const char* a2 = last ? nA : cA + (size_t)(t + 2) * kstep; const char* b2 = last ? nB : cB + (size_t)(t + 2) * kstep;
            const char* a3 = a2 + kstep; const char* b3 = b2 + kstep;
            if (last && has_next) S.a_ready(nxt);
            if constexpr (SP2) {
            PG8_LDB(B0, 0, 0); PG8_LDB(B1, 0, 1); PG8_SCHED; PG8_LDA(At, 0, 0); PG8_STAGE(PG8_SA(1, 1), a1 + hstep, voffA);
            PG8_WAIT_V(8); PG8_WAIT_L(0); PG8_BAR; PG8_MMA(0, 0, At, B0); PG8_MMA(0, 1, At, B1); PG8_BAR; PG8_SCHED;
            PG8_LDA(At, 0, 1); PG8_STAGE(PG8_SB(0, 0), b2, voffB); PG8_STAGE(PG8_SB(0, 1), b2 + hstep, voffB); PG8_STAGE(PG8_SA(0, 0), a2, voffA);
            PG8_WAIT_V(8); PG8_WAIT_L(0); PG8_BAR; PG8_MMA(1, 0, At, B0); PG8_MMA(1, 1, At, B1); PG8_BAR; PG8_SCHED;
            PG8_LDB(B0, 1, 0); PG8_LDB(B1, 1, 1); PG8_SCHED; PG8_LDA(At, 1, 0); PG8_STAGE(PG8_SA(0, 1), a2 + hstep, voffA);
            PG8_WAIT_V(8); PG8_WAIT_L(0); PG8_BAR; PG8_MMA(0, 0, At, B0); PG8_MMA(0, 1, At, B1); PG8_BAR; PG8_SCHED;
            PG8_LDA(At, 1, 1); PG8_STAGE(PG8_SB(1, 0), b3, voffB); PG8_STAGE(PG8_SB(1, 1), b3 + hstep, voffB); PG8_STAGE(PG8_SA(1, 0), a3, voffA);
            PG8_WAIT_V(8); PG8_WAIT_L(0); PG8_BAR; PG8_MMA(1, 0, At, B0); PG8_MMA(1, 1, At, B1); PG8_BAR; PG8_SCHED;
            } else {
            PG8_LDB(B0, 0, 0); PG8_SCHED; PG8_LDA(At, 0, 0); PG8_STAGE(PG8_SA(1, 1), a1 + hstep, voffA);
            PG8_WAIT_L(8); PG8_BAR; PG8_WAIT_L(0); PG8_MMA(0, 0, At, B0); PG8_BAR; PG8_SCHED;
            PG8_LDB(B1, 0, 1); PG8_STAGE(PG8_SB(0, 0), b2, voffB);
            PG8_BAR; PG8_WAIT_L(0); PG8_MMA(0, 1, At, B1); PG8_BAR;
            PG8_LDA(At, 0, 1); PG8_STAGE(PG8_SA(0, 0), a2, voffA);
            PG8_BAR; PG8_WAIT_L(0); PG8_MMA(1, 0, At, B0); PG8_BAR; PG8_SCHED;
            PG8_STAGE(PG8_SB(0, 1), b2 + hstep, voffB);
            PG8_WAIT_V(6); PG8_BAR; PG8_MMA(1, 1, At, B1); PG8_BAR;
            PG8_LDB(B0, 1, 0); PG8_SCHED; PG8_LDA(At, 1, 0); PG8_STAGE(PG8_SA(0, 1), a2 + hstep, voffA);
            PG8_WAIT_L(8); PG8_BAR; PG8_WAIT_L(0); PG8_MMA(0, 0, At, B0); PG8_BAR; PG8_SCHED;
            PG8_LDB(B1, 1, 1); PG8_STAGE(PG8_SB(1, 0), b3, voffB);
            PG8_BAR; PG8_WAIT_L(0); PG8_MMA(0, 1, At, B1); PG8_BAR;
            PG8_LDA(At, 1, 1); PG8_STAGE(PG8_SA(1, 0), a3, voffA);
            PG8_BAR; PG8_WAIT_L(0); PG8_MMA(1, 0, At, B0); PG8_BAR; PG8_SCHED;
            PG8_STAGE(PG8_SB(1, 1), b3 + hstep, voffB);
            PG8_WAIT_V(6); PG8_BAR; PG8_MMA(1, 1, At, B1); PG8_BAR;
            }
        }
        if constexpr (ALIGN_EPI) { if (wr == 0) PG8_BAR; }
        if constexpr (!Epi::AFTER_DRAIN) { E(acc, cur, wr, wc, fr, fq); S.done(cur); }
        if (!has_next) break;
#pragma unroll
        for (int a = 0; a < 2; ++a)
#pragma unroll
            for (int b = 0; b < 2; ++b)
#pragma unroll
                for (int m = 0; m < 4; ++m)
#pragma unroll
                    for (int n = 0; n < 2; ++n) acc[a][b][m][n] = (f32x4){0.f, 0.f, 0.f, 0.f};
        cur = nxt; cA = nA; cB = nB; ++ui;
        if constexpr (ALIGN_EPI) { if (wr == 1) PG8_BAR; }
    }
    PG8_WAIT_V(0);
    if constexpr (!ALIGN_EPI) { if (wr == 0) PG8_BAR; }
    PG8_BAR;
    if constexpr (Epi::AFTER_DRAIN) { E.fused(acc, cur, wr, wc, fr, fq, lds, wid, lane); S.done(cur); }
#undef PG8_SA
#undef PG8_SB
#undef PG8_STAGE
#undef PG8_LDA
#undef PG8_LDB
#undef PG8_MMA
#undef PG8_WAIT_V
#undef PG8_WAIT_L
#undef PG8_BAR
#undef PG8_SCHED
}
}

#define LAS __attribute__((address_space(3)))
using pg8::bf16_t; using pg8::f32x4; using pg8::u32x4; using pg8::Unit; using pg8::cvt_pk_bf16;
typedef short bf16x8 __attribute__((ext_vector_type(8)));
typedef float f32x16 __attribute__((ext_vector_type(16)));
typedef unsigned u32x2 __attribute__((ext_vector_type(2)));
typedef short v4i16_t __attribute__((ext_vector_type(4)));

constexpr int M_TOK = 16384, SEQ = 4096, DM = 2048, DFF = 5632, NWIN = 3584;
constexpr float EPS = 1e-6f, LOG2E = 1.4426950408889634f;
constexpr float QSCALE = 0.07216878364870322f * 1.4426950408889634f;
constexpr float SBSCALE = 0.08838834764831845f * 1.4426950408889634f;

constexpr size_t MiB = 1u << 20;
constexpr size_t WS_CTL = 0, WS_RSTD = 512 * 1024;
constexpr size_t WS_W = 1 * MiB, W_LAYER = 167 * MiB;
constexpr size_t WO_FF1IN = 0, WO_FF1OUT = 44 * MiB, WO_IN = 66 * MiB, WO_UQ = 80 * MiB, WO_UKV = 82 * MiB, WO_PW = 83 * MiB,
                 WO_OUT = 84 * MiB, WO_FF2IN = 92 * MiB, WO_FF2OUT = 136 * MiB, WO_GATE = 158 * MiB, WO_PROJ = 166 * MiB;
static_assert(WO_PROJ + 2048 * 256 * 2 <= W_LAYER, "weights map");
constexpr size_t WS_HID = 335 * MiB;
constexpr size_t WS_CQ = WS_HID, WS_CKV = WS_HID + 16 * MiB, WS_GLU = WS_HID + 24 * MiB, WS_SBQ = WS_HID + 40 * MiB, WS_SBK = WS_HID + 56 * MiB,
                 WS_SBV = WS_HID + 72 * MiB, WS_KR = WS_HID + 88 * MiB, WS_SSQ = WS_HID + 90 * MiB, WS_MIX = WS_HID + 91 * MiB;
static_assert(WS_MIX + 64 * MiB <= WS_HID + 176 * MiB && WS_SBV - WS_SBK == WS_SBK - WS_SBQ, "hid overlay");
constexpr size_t WS_F = 511 * MiB;
constexpr size_t WS_Q = WS_F, WS_KN = WS_F + 48 * MiB, WS_V = WS_F + 80 * MiB, WS_CV = WS_F + 112 * MiB;
constexpr size_t WS_XN = 639 * MiB;
constexpr size_t WS_PB = 703 * MiB;
constexpr size_t WS_COS = 719 * MiB, WS_SIN = 721 * MiB;
constexpr size_t WS_EB = 723 * MiB;
constexpr size_t WS_END = 787 * MiB;

constexpr int LDS_BYTES = 147456;
constexpr int MISC_OFF = 131072;
constexpr int CW_BAR = 4096;

__device__ __forceinline__ int otid() { int t = threadIdx.x; asm volatile("" : "+v"(t)); return t; }
__device__ __forceinline__ float wave_sum(float v) {
#pragma unroll
    for (int o = 1; o < 64; o <<= 1) v += __shfl_xor(v, o);
    return v;
}
__device__ __forceinline__ float fexp2(float x) { return __builtin_amdgcn_exp2f(x); }
__device__ __forceinline__ float frcp(float x) { return __builtin_amdgcn_rcpf(x); }
__device__ __forceinline__ float sigmoidf_(float x) { return frcp(1.0f + fexp2(-x * LOG2E)); }
__device__ __forceinline__ void st8(bf16_t* p, f32x4 v0, f32x4 v1) {
    u32x4 w; w.x = cvt_pk_bf16(v0[0], v0[1]); w.y = cvt_pk_bf16(v0[2], v0[3]); w.z = cvt_pk_bf16(v1[0], v1[1]); w.w = cvt_pk_bf16(v1[2], v1[3]);
    *(u32x4*)p = w;
}
__device__ __forceinline__ void st4(bf16_t* p, f32x4 v) { u32x2 w; w.x = cvt_pk_bf16(v[0], v[1]); w.y = cvt_pk_bf16(v[2], v[3]); *(u32x2*)p = w; }
__device__ __forceinline__ float dot4(f32x4 a) { return (a[0] * a[0] + a[1] * a[1]) + (a[2] * a[2] + a[3] * a[3]); }

#define EPI_ROWS for (int ai = 0; ai < 2; ++ai) _Pragma("unroll") for (int m = 0; m < 4; ++m)
#define LOAD_RS(rsv, ptr, row0) float rsv[2][4]; _Pragma("unroll") for (int ai = 0; ai < 2; ++ai) _Pragma("unroll") for (int m = 0; m < 4; ++m) rsv[ai][m] = (ptr)[(row0) + ai * 128 + m * 16];
struct EpiSwiglu {
    static constexpr bool PERM = true, AFTER_DRAIN = false;
    bf16_t* H; const float* rstd;
    __device__ __forceinline__ void operator()(const f32x4 (&acc)[2][2][4][2], const Unit& u, int wr, int wc, int fr, int fq) const {
        asm volatile("" : "+v"(fr), "+v"(fq));
        const int row0 = u.pm * 256 + wr * 64 + fr, col = u.pn * 128 + wc * 32 + 8 * fq;
        LOAD_RS(rsv, rstd, row0)
#pragma unroll
        EPI_ROWS { const int row = row0 + ai * 128 + m * 16; const float rs = rsv[ai][m], nrs = rs * (-LOG2E), rs2 = rs * rs; f32x4 o[2];
#pragma unroll
            for (int n = 0; n < 2; ++n) { const f32x4 a = acc[ai][0][m][n], g = acc[ai][1][m][n]; const f32x4 ag = a * g, t = a * nrs; f32x4 w;
#pragma unroll
                for (int e = 0; e < 4; ++e) w[e] = frcp(1.0f + fexp2(t[e]));
                o[n] = ag * (w * rs2); }
            st8(H + (size_t)row * DFF + col, o[0], o[1]); }
    }
};
struct EpiF32 {
    static constexpr bool PERM = true, AFTER_DRAIN = false;
    float* O; int ldc;
    __device__ __forceinline__ void operator()(const f32x4 (&acc)[2][2][4][2], const Unit& u, int wr, int wc, int fr, int fq) const {
        asm volatile("" : "+v"(fr), "+v"(fq));
        const int row0 = u.pm * 256 + wr * 64 + fr, col = u.pn * 256 + wc * 32 + 8 * fq;
#pragma unroll
        EPI_ROWS { float* p = O + (size_t)(row0 + ai * 128 + m * 16) * ldc + col;
#pragma unroll
            for (int bj = 0; bj < 2; ++bj) { *(f32x4*)(p + bj * 128) = acc[ai][bj][m][0]; *(f32x4*)(p + bj * 128 + 4) = acc[ai][bj][m][1]; } }
    }
};
struct EpiBf {
    static constexpr bool PERM = true, AFTER_DRAIN = false;
    bf16_t* O; int ldc;
    __device__ __forceinline__ void operator()(const f32x4 (&acc)[2][2][4][2], const Unit& u, int wr, int wc, int fr, int fq) const {
        asm volatile("" : "+v"(fr), "+v"(fq));
        const int row0 = u.pm * 256 + wr * 64 + fr, col = u.pn * 256 + wc * 32 + 8 * fq;
#pragma unroll
        EPI_ROWS { bf16_t* p = O + (size_t)(row0 + ai * 128 + m * 16) * ldc + col;
#pragma unroll
            for (int bj = 0; bj < 2; ++bj) st8(p + bj * 128, acc[ai][bj][m][0], acc[ai][bj][m][1]); }
    }
};
struct EpiGate {
    static constexpr bool PERM = true, AFTER_DRAIN = false;
    bf16_t* O; const bf16_t* Eb; const float* rstd;
    __device__ __forceinline__ void operator()(const f32x4 (&acc)[2][2][4][2], const Unit& u, int wr, int wc, int fr, int fq) const {
        asm volatile("" : "+v"(fr), "+v"(fq));
        const int row0 = u.pm * 256 + wr * 64 + fr, col = u.pn * 256 + wc * 32 + 8 * fq;
        LOAD_RS(rsv, rstd, row0)
#pragma unroll
        EPI_ROWS { const int row = row0 + ai * 128 + m * 16; const float rs = rsv[ai][m]; const size_t off = (size_t)row * DM + col;
#pragma unroll
            for (int bj = 0; bj < 2; ++bj) { const u32x4 ev = *(const u32x4*)(Eb + off + bj * 128); f32x4 o0, o1;
                const f32x4 a0 = acc[ai][bj][m][0] * rs, a1 = acc[ai][bj][m][1] * rs;
                o0[0] = sigmoidf_(a0[0]) * __uint_as_float(ev.x << 16); o0[1] = sigmoidf_(a0[1]) * __uint_as_float(ev.x & 0xffff0000u);
                o0[2] = sigmoidf_(a0[2]) * __uint_as_float(ev.y << 16); o0[3] = sigmoidf_(a0[3]) * __uint_as_float(ev.y & 0xffff0000u);
                o1[0] = sigmoidf_(a1[0]) * __uint_as_float(ev.z << 16); o1[1] = sigmoidf_(a1[1]) * __uint_as_float(ev.z & 0xffff0000u);
                o1[2] = sigmoidf_(a1[2]) * __uint_as_float(ev.w << 16); o1[3] = sigmoidf_(a1[3]) * __uint_as_float(ev.w & 0xffff0000u);
                st8(O + off + bj * 128, o0, o1); } }
    }
};
struct EpiWin {
    static constexpr bool PERM = true, AFTER_DRAIN = false;
    unsigned char* wsb;
    __device__ __forceinline__ void operator()(const f32x4 (&acc)[2][2][4][2], const Unit& u, int wr, int wc, int fr, int fq) const {
        asm volatile("" : "+v"(fr), "+v"(fq));
        const int pn = u.pn, row0 = u.pm * 256 + wr * 64 + fr, cw = wc * 32 + 8 * fq;
        bf16_t* glu = (bf16_t*)(wsb + WS_GLU); bf16_t* kr = (bf16_t*)(wsb + WS_KR); float* ssq = (float*)(wsb + WS_SSQ);
        const float* rstd = (const float*)(wsb + WS_RSTD);
        LOAD_RS(rsv, rstd, row0)
        const float* ccos = (const float*)(wsb + WS_COS); const float* csin = (const float*)(wsb + WS_SIN);
        if (pn <= 2) {
            bf16_t* base = (bf16_t*)(wsb + (pn < 2 ? WS_CQ : WS_CKV)); const int ld = pn < 2 ? 512 : 256, cb = (pn == 1 ? 256 : 0) + cw;
#pragma unroll
            EPI_ROWS { const int row = row0 + ai * 128 + m * 16; const float rs = rsv[ai][m]; float ss = 0.f;
#pragma unroll
                for (int bj = 0; bj < 2; ++bj) { const f32x4 v0 = acc[ai][bj][m][0] * rs, v1 = acc[ai][bj][m][1] * rs; st8(base + (size_t)row * ld + cb + bj * 128, v0, v1); ss += dot4(v0) + dot4(v1); }
                ss += __shfl_xor(ss, 16); ss += __shfl_xor(ss, 32);
                if (fq == 0) ssq[(size_t)row * 12 + pn * 4 + wc] = ss; }
        } else if (pn <= 6) {
            const int col = (pn - 3) * 128 + cw;
#pragma unroll
            EPI_ROWS { const int row = row0 + ai * 128 + m * 16; const float rs = rsv[ai][m]; f32x4 o[2];
#pragma unroll
                for (int n = 0; n < 2; ++n) { const f32x4 a = acc[ai][0][m][n] * rs, g = acc[ai][1][m][n] * rs;
#pragma unroll
                    for (int e = 0; e < 4; ++e) o[n][e] = a[e] * sigmoidf_(g[e]); }
                st8(glu + (size_t)row * 512 + col, o[0], o[1]); }
        } else if (pn <= 12) {
            const int which = (pn - 7) >> 1; bf16_t* base = (bf16_t*)(wsb + WS_SBQ + (size_t)which * (WS_SBK - WS_SBQ)); const float sc = which == 0 ? SBSCALE : 1.0f;
            const int cb = ((pn - 7) & 1) * 256 + cw;
#pragma unroll
            EPI_ROWS { const int row = row0 + ai * 128 + m * 16; const float rs = rsv[ai][m] * sc;
#pragma unroll
                for (int bj = 0; bj < 2; ++bj) st8(base + (size_t)row * 512 + cb + bj * 128, acc[ai][bj][m][0] * rs, acc[ai][bj][m][1] * rs); }
        } else {
            if (wc == 0) {
#pragma unroll
                EPI_ROWS { const int row = row0 + ai * 128 + m * 16;
#pragma unroll
                    for (int n = 0; n < 2; ++n) { const int j0 = 8 * fq + 4 * n; const f32x4 c4 = *(const f32x4*)(ccos + (size_t)row * 32 + j0), s4 = *(const f32x4*)(csin + (size_t)row * 32 + j0);
                        const float rs = rsv[ai][m]; const f32x4 x1 = acc[ai][0][m][n] * rs, x2 = acc[ai][1][m][n] * rs;
                        st4(kr + (size_t)row * 64 + j0, x1 * c4 - x2 * s4); st4(kr + (size_t)row * 64 + 32 + j0, x1 * s4 + x2 * c4); } }
            }
        }
    }
};
struct EpiUq {
    static constexpr bool PERM = true, AFTER_DRAIN = false;
    bf16_t* Q; const float* ssq; const float* ccos; const float* csin;
    __device__ __forceinline__ void operator()(const f32x4 (&acc)[2][2][4][2], const Unit& u, int wr, int wc, int fr, int fq) const {
        asm volatile("" : "+v"(fr), "+v"(fq));
        const int pn = u.pn, row0 = u.pm * 256 + wr * 64 + fr, cw = wc * 32 + 8 * fq;
#pragma unroll
        for (int ai = 0; ai < 2; ++ai) {
        f32x4 pa[4], pb[4];
#pragma unroll
        for (int m = 0; m < 4; ++m) { const int row = row0 + ai * 128 + m * 16; pa[m] = *(const f32x4*)(ssq + (size_t)row * 12); pb[m] = *(const f32x4*)(ssq + (size_t)row * 12 + 4); }
#pragma unroll
        for (int m = 0; m < 4; ++m) { const int row = row0 + ai * 128 + m * 16;
            const f32x4 p0 = pa[m], p1 = pb[m];
            const float s = ((p0[0] + p0[1]) + (p0[2] + p0[3])) + ((p1[0] + p1[1]) + (p1[2] + p1[3]));
            const float rs = rsqrtf(s * (1.0f / 512.0f) + EPS) * QSCALE;
            if (pn < 4) {
#pragma unroll
                for (int bj = 0; bj < 2; ++bj) st8(Q + (size_t)row * 1536 + (2 * pn + bj) * 192 + cw, acc[ai][bj][m][0] * rs, acc[ai][bj][m][1] * rs);
            } else {
                bf16_t* qh = Q + (size_t)row * 1536 + (4 * (pn - 4) + wc) * 192 + 128;
#pragma unroll
                for (int n = 0; n < 2; ++n) { const int j0 = 8 * fq + 4 * n; const f32x4 c4 = *(const f32x4*)(ccos + (size_t)row * 32 + j0), s4 = *(const f32x4*)(csin + (size_t)row * 32 + j0);
                    const f32x4 x1 = acc[ai][0][m][n] * rs, x2 = acc[ai][1][m][n] * rs;
                    st4(qh + j0, x1 * c4 - x2 * s4); st4(qh + 32 + j0, x1 * s4 + x2 * c4); }
            }
        }
        }
    }
};
struct EpiUkv {
    static constexpr bool PERM = true, AFTER_DRAIN = false;
    bf16_t* Kn; bf16_t* V; const float* ssq;
    __device__ __forceinline__ void operator()(const f32x4 (&acc)[2][2][4][2], const Unit& u, int wr, int wc, int fr, int fq) const {
        asm volatile("" : "+v"(fr), "+v"(fq));
        const int row0 = u.pm * 256 + wr * 64 + fr, col = u.pn * 128 + wc * 32 + 8 * fq;
        f32x4 pa[2][4];
#pragma unroll
        EPI_ROWS { pa[ai][m] = *(const f32x4*)(ssq + (size_t)(row0 + ai * 128 + m * 16) * 12 + 8); }
#pragma unroll
        EPI_ROWS { const int row = row0 + ai * 128 + m * 16;
            const f32x4 p0 = pa[ai][m];
            const float rs = rsqrtf(((p0[0] + p0[1]) + (p0[2] + p0[3])) * (1.0f / 256.0f) + EPS);
            st8(Kn + (size_t)row * 1024 + col, acc[ai][0][m][0] * rs, acc[ai][0][m][1] * rs);
            st8(V + (size_t)row * 1024 + col, acc[ai][1][m][0] * rs, acc[ai][1][m][1] * rs); }
    }
};

namespace att {
constexpr int ST_KN = 0, ST_V = 16384, ST_KR = 32768, ST_BYTES = 40960;
__device__ __forceinline__ int offb(int row, int ch) { return 256 * row + 16 * (ch ^ (((row & 3) << 2) | ((row >> 2) & 3))); }
__device__ __forceinline__ int off64(int row, int ch) { return 128 * row + 16 * (ch ^ ((row >> 1) & 7)); }
__device__ __forceinline__ bf16x8 mk8(v4i16_t lo, v4i16_t hi) { return (bf16x8){lo[0], lo[1], lo[2], lo[3], hi[0], hi[1], hi[2], hi[3]}; }
__device__ __forceinline__ v4i16_t trrd(LAS unsigned char* p) { return __builtin_amdgcn_ds_read_tr16_b64_v4i16((LAS v4i16_t*)p); }
__device__ __forceinline__ bf16x8 pack8(float a0, float a1, float a2, float a3, float a4, float a5, float a6, float a7) {
    u32x4 w; w.x = cvt_pk_bf16(a0, a1); w.y = cvt_pk_bf16(a2, a3); w.z = cvt_pk_bf16(a4, a5); w.w = cvt_pk_bf16(a6, a7);
    return __builtin_bit_cast(bf16x8, w);
}
__device__ __forceinline__ void pair32(float v, float& lo, float& hi_) { const auto rr = __builtin_amdgcn_permlane32_swap(__float_as_uint(v), __float_as_uint(v), false, false); lo = __uint_as_float(rr[0]); hi_ = __uint_as_float(rr[1]); }
__device__ __forceinline__ void sb_block(f32x16& S, float& running, int hi) {
#pragma unroll
    for (int gq = 3; gq >= 0; --gq) {
        float bt[4], kp[4];
#pragma unroll
        for (int e = 0; e < 4; ++e) { const float ee = fexp2(-S[4 * gq + e]); bt[e] = frcp(1.0f + ee); kp[e] = 1.0f - bt[e]; }
        const float own = (kp[0] * kp[1]) * (kp[2] * kp[3]); float plo, phi; pair32(own, plo, phi);
        float E = running * (hi ? 1.0f : phi);
        S[4 * gq + 3] = bt[3] * E; E *= kp[3];
        S[4 * gq + 2] = bt[2] * E; E *= kp[2];
        S[4 * gq + 1] = bt[1] * E; E *= kp[1];
        S[4 * gq + 0] = bt[0] * E;
        running *= plo * phi;
    }
}

template <bool SB>
__device__ __forceinline__ void attn_unit(LAS unsigned char* lds, const bf16_t* __restrict__ Q, int qp, const bf16_t* __restrict__ K, int kp,
                                          const bf16_t* __restrict__ V, int vp, const bf16_t* __restrict__ KR, bf16_t* O, int tokbase, int qblk) {
    constexpr int NDN = 8, NDR = SB ? 0 : 4, ND = NDN + NDR;
    const int tid = otid(), lane = tid & 63, wid = __builtin_amdgcn_readfirstlane(tid >> 6), r32 = lane & 31, hi = lane >> 5;
    const bool lead = wid < 4;
    const int qw0 = qblk * 256 + wid * 32, tq = qw0 + r32;
    bf16x8 qf[ND];
    { const bf16_t* qrow = Q + (size_t)(tokbase + tq) * qp + 8 * hi;
#pragma unroll
      for (int ds = 0; ds < ND; ++ds) qf[ds] = *(const bf16x8*)(qrow + 16 * ds); }
    f32x16 o[4];
#pragma unroll
    for (int d0 = 0; d0 < 4; ++d0)
#pragma unroll
        for (int r = 0; r < 16; ++r) o[d0][r] = 0.f;
    float m_run = -1e30f, l_run = 0.f, running = 1.0f;
    const int NT = (qblk + 1) * 4;
    const bf16_t* gK; const bf16_t* gV; const bf16_t* gR = nullptr;
    { const int row = 4 * wid + (lane >> 4), ch = (lane & 15) ^ (((row & 3) << 2) | ((row >> 2) & 3));
      gK = K + (size_t)(tokbase + row) * kp + ch * 8; gV = V + (size_t)(tokbase + row) * vp + ch * 8;
      if (!SB) { const int rr = 8 * wid + (lane >> 3), cr = (lane & 7) ^ ((rr >> 1) & 7); gR = KR + (size_t)(tokbase + rr) * 64 + cr * 8; } }
    const unsigned pcs = (unsigned)wid * 1024u;
#define ATT_DMA(T, stw) do { const size_t ko = (size_t)(T) * 64 * kp, vo = (size_t)(T) * 64 * vp; \
        __builtin_amdgcn_global_load_lds((const unsigned*)(gK + ko), (LAS unsigned*)((stw) + ST_KN + pcs), 16, 0, 0); \
        __builtin_amdgcn_global_load_lds((const unsigned*)(gK + ko + (size_t)32 * kp), (LAS unsigned*)((stw) + ST_KN + 8192 + pcs), 16, 0, 0); \
        __builtin_amdgcn_global_load_lds((const unsigned*)(gV + vo), (LAS unsigned*)((stw) + ST_V + pcs), 16, 0, 0); \
        __builtin_amdgcn_global_load_lds((const unsigned*)(gV + vo + (size_t)32 * vp), (LAS unsigned*)((stw) + ST_V + 8192 + pcs), 16, 0, 0); \
        if (!SB) __builtin_amdgcn_global_load_lds((const unsigned*)(gR + (size_t)(T) * 64 * 64), (LAS unsigned*)((stw) + ST_KR + pcs), 16, 0, 0); } while (0)
#define ATT_BAR(more) do { if (more) { if (SB) asm volatile("s_waitcnt vmcnt(4) lgkmcnt(0)" ::: "memory"); else asm volatile("s_waitcnt vmcnt(5) lgkmcnt(0)" ::: "memory"); } \
        else asm volatile("s_waitcnt vmcnt(0) lgkmcnt(0)" ::: "memory"); __builtin_amdgcn_s_barrier(); asm volatile("" ::: "memory"); } while (0)
#define ATT_SB() __builtin_amdgcn_sched_barrier(0)
#define ATT_TILE(t_) (SB ? NT - 1 - (t_) : (t_))
    const int xk = ((r32 & 3) << 2) | ((r32 >> 2) & 3);
    const int krow = 256 * r32, rrw = 128 * r32, xr = (r32 >> 1) & 7;
    const int g4 = lane >> 4, tq4 = (lane & 15) >> 2, tp = lane & 3;
    f32x16 s0, s1;
#define ATT_KFRAG(dst, i, ds, stq) do { if ((ds) < NDN) { const int co = 16 * ((2 * (ds) + hi) ^ xk); \
            dst[2 * (i)] = *(const LAS bf16x8*)((stq) + ST_KN + krow + co); dst[2 * (i) + 1] = *(const LAS bf16x8*)((stq) + ST_KN + 8192 + krow + co); } \
        else { const int co = 16 * ((2 * ((ds) - NDN) + hi) ^ xr); \
            dst[2 * (i)] = *(const LAS bf16x8*)((stq) + ST_KR + rrw + co); dst[2 * (i) + 1] = *(const LAS bf16x8*)((stq) + ST_KR + 4096 + rrw + co); } } while (0)
#define ATT_QK(stq) do { \
        _Pragma("unroll") for (int r = 0; r < 16; ++r) { s0[r] = 0.f; s1[r] = 0.f; } \
        bf16x8 fa[4], fb[4]; \
        ATT_KFRAG(fa, 0, 0, stq); ATT_KFRAG(fa, 1, 1, stq); ATT_SB(); \
        _Pragma("unroll") for (int b = 0; b < ND / 2; b += 2) { \
            if (b + 1 < ND / 2) { ATT_KFRAG(fb, 0, 2 * b + 2, stq); ATT_KFRAG(fb, 1, 2 * b + 3, stq); } ATT_SB(); \
            s0 = __builtin_amdgcn_mfma_f32_32x32x16_bf16(fa[0], qf[2 * b], s0, 0, 0, 0); s1 = __builtin_amdgcn_mfma_f32_32x32x16_bf16(fa[1], qf[2 * b], s1, 0, 0, 0); \
            s0 = __builtin_amdgcn_mfma_f32_32x32x16_bf16(fa[2], qf[2 * b + 1], s0, 0, 0, 0); s1 = __builtin_amdgcn_mfma_f32_32x32x16_bf16(fa[3], qf[2 * b + 1], s1, 0, 0, 0); ATT_SB(); \
            if (b + 1 < ND / 2) { \
                if (b + 2 < ND / 2) { ATT_KFRAG(fa, 0, 2 * b + 4, stq); ATT_KFRAG(fa, 1, 2 * b + 5, stq); } ATT_SB(); \
                s0 = __builtin_amdgcn_mfma_f32_32x32x16_bf16(fb[0], qf[2 * b + 2], s0, 0, 0, 0); s1 = __builtin_amdgcn_mfma_f32_32x32x16_bf16(fb[1], qf[2 * b + 2], s1, 0, 0, 0); \
                s0 = __builtin_amdgcn_mfma_f32_32x32x16_bf16(fb[2], qf[2 * b + 3], s0, 0, 0, 0); s1 = __builtin_amdgcn_mfma_f32_32x32x16_bf16(fb[3], qf[2 * b + 3], s1, 0, 0, 0); ATT_SB(); } } \
    } while (0)
#define ATT_VFRAG(dst, ks, stv) do { \
        _Pragma("unroll") for (int d0 = 0; d0 < 4; ++d0) { \
            const int c = 4 * d0 + 2 * (g4 & 1) + (tp >> 1); \
            const int rowa = 4 * (g4 >> 1) + tq4, rowb = rowa + 8; \
            const int a0 = 256 * rowa + 16 * (c ^ (((rowa & 3) << 2) | ((rowa >> 2) & 3))) + 8 * (tp & 1); \
            const int a1 = 256 * rowb + 16 * (c ^ (((rowb & 3) << 2) | ((rowb >> 2) & 3))) + 8 * (tp & 1); \
            dst[d0] = mk8(trrd((stv) + ST_V + a0 + (ks) * 4096), trrd((stv) + ST_V + a1 + (ks) * 4096)); } } while (0)
#define ATT_SMPV(k0v, stv) do { \
        const int k0_ = (k0v); \
        bf16x8 va[4], vb[4]; \
        ATT_VFRAG(va, 0, stv); ATT_SB(); \
        if (k0_ + 63 >= qw0) { asm volatile("; tile on the causal diagonal: mask" ::: "memory");     \
            _Pragma("unroll") for (int r = 0; r < 16; ++r) { const int kv = k0_ + (r & 3) + 8 * (r >> 2) + 4 * hi + (SB ? 1 : 0); if (kv > tq) s0[r] = -1e30f; if (kv + 32 > tq) s1[r] = -1e30f; } } \
        if (SB) { sb_block(s1, running, hi); sb_block(s0, running, hi); } \
        else { \
            asm volatile("s_nop 15\n\ts_nop 7" : "+v"(s0), "+v"(s1));     \
            float mx; asm("v_max_f32_e32 %0, %1, %2" : "=v"(mx) : "v"(s0[0]), "v"(s1[0])); \
            _Pragma("unroll") for (int r = 1; r < 16; ++r) asm("v_max3_f32 %0, %1, %2, %3" : "=v"(mx) : "v"(mx), "v"(s0[r]), "v"(s1[r]));     \
            { float mlo, mhi; pair32(mx, mlo, mhi); mx = fmaxf(mlo, mhi); } \
            const bool grew = mx > m_run + 4.0f;     \
            const float mn = grew ? mx : m_run, alpha = fexp2(m_run - mn); \
            m_run = mn; \
            float ls = 0.f; \
            _Pragma("unroll") for (int r = 0; r < 16; ++r) { s0[r] = fexp2(s0[r] - mn); s1[r] = fexp2(s1[r] - mn); ls += s0[r] + s1[r]; } \
            l_run = l_run * alpha + ls; \
            if (__any(grew)) { _Pragma("unroll") for (int d0 = 0; d0 < 4; ++d0) _Pragma("unroll") for (int r = 0; r < 16; ++r) o[d0][r] *= alpha; } \
        } \
        bf16x8 pf[4]; \
        pf[0] = pack8(s0[0], s0[1], s0[2], s0[3], s0[4], s0[5], s0[6], s0[7]); \
        pf[1] = pack8(s0[8], s0[9], s0[10], s0[11], s0[12], s0[13], s0[14], s0[15]); \
        pf[2] = pack8(s1[0], s1[1], s1[2], s1[3], s1[4], s1[5], s1[6], s1[7]); \
        pf[3] = pack8(s1[8], s1[9], s1[10], s1[11], s1[12], s1[13], s1[14], s1[15]); \
        ATT_SB(); ATT_VFRAG(vb, 1, stv); ATT_SB(); \
        _Pragma("unroll") for (int d0 = 0; d0 < 4; ++d0) o[d0] = __builtin_amdgcn_mfma_f32_32x32x16_bf16(va[d0], pf[0], o[d0], 0, 0, 0); \
        ATT_SB(); ATT_VFRAG(va, 2, stv); ATT_SB(); \
        _Pragma("unroll") for (int d0 = 0; d0 < 4; ++d0) o[d0] = __builtin_amdgcn_mfma_f32_32x32x16_bf16(vb[d0], pf[1], o[d0], 0, 0, 0); \
        ATT_SB(); ATT_VFRAG(vb, 3, stv); ATT_SB(); \
        _Pragma("unroll") for (int d0 = 0; d0 < 4; ++d0) o[d0] = __builtin_amdgcn_mfma_f32_32x32x16_bf16(va[d0], pf[2], o[d0], 0, 0, 0); \
        ATT_SB(); \
        _Pragma("unroll") for (int d0 = 0; d0 < 4; ++d0) o[d0] = __builtin_amdgcn_mfma_f32_32x32x16_bf16(vb[d0], pf[3], o[d0], 0, 0, 0); \
    } while (0)
    ATT_DMA(ATT_TILE(0), lds);
    ATT_DMA(ATT_TILE(1), lds + ST_BYTES);
    ATT_BAR(true);
    if (!lead) ATT_BAR(true);
    int cur = 0;
    for (int t = 0; t < NT; ++t) {
        LAS unsigned char* stc = lds + cur * ST_BYTES;
        LAS unsigned char* stn = lds + (cur == 0 ? 2 : cur - 1) * ST_BYTES;
        const int k0 = ATT_TILE(t) * 64;
        const bool act = (k0 <= qw0 + 31);
        const bool more = t + 2 < NT;
        if (!lead && more) ATT_DMA(ATT_TILE(t + 2), stn);
        if (act) { ATT_QK(stc); }
        ATT_BAR(lead ? (t + 1 < NT) : more);
        if (lead && more) ATT_DMA(ATT_TILE(t + 2), stn);
        if (act) { ATT_SMPV(k0, stc); }
        ATT_BAR(more);
        cur = (cur == 2) ? 0 : cur + 1;
    }
    if (lead) ATT_BAR(false);
#undef ATT_DMA
#undef ATT_BAR
#undef ATT_SB
#undef ATT_TILE
#undef ATT_KFRAG
#undef ATT_QK
#undef ATT_VFRAG
#undef ATT_SMPV
    float inv = 1.0f;
    if (!SB) { float llo, lhi; pair32(l_run, llo, lhi); inv = 1.0f / (llo + lhi); }
    bf16_t* orow = O + (size_t)(tokbase + tq) * DM + 4 * hi;
#pragma unroll
    for (int d0 = 0; d0 < 4; ++d0)
#pragma unroll
        for (int gq = 0; gq < 4; ++gq) {
            f32x4 v; v[0] = o[d0][4 * gq] * inv; v[1] = o[d0][4 * gq + 1] * inv; v[2] = o[d0][4 * gq + 2] * inv; v[3] = o[d0][4 * gq + 3] * inv;
            st4(orow + 32 * d0 + 8 * gq, v);
        }
}
}

__device__ __forceinline__ int srccol(int mode, int nb) {
    if (mode == 0) return 32 * nb;
    if (mode == 1) { const int pn = nb >> 3, q = nb & 7; return (q >> 2) * DFF + 128 * pn + 32 * (q & 3); }
    if (mode == 2) {
        if (nb < 16) return 32 * nb;
        if (nb < 24) return 512 + 32 * (nb - 16);
        if (nb < 56) { const int t = (nb - 24) >> 3, q = (nb - 24) & 7; return 832 + (q >> 2) * 512 + 128 * t + 32 * (q & 3); }
        if (nb < 104) return 1856 + 32 * (nb - 56);
        if (nb == 104) return 768;
        if (nb == 108) return 800;
        return -1;
    }
    if (nb < 32) return 192 * (nb >> 2) + 32 * (nb & 3);
    { const int t = (nb - 32) >> 3, q = (nb - 32) & 7; return 192 * (4 * t + (q & 3)) + 128 + 32 * (q >> 2); }
}
__device__ __forceinline__ unsigned f2bf(float f) { unsigned u = __builtin_bit_cast(unsigned, f); return (u + 0x7fffu + ((u >> 16) & 1u)) >> 16; }
__device__ __forceinline__ unsigned pk2(float lo, float hi) { return f2bf(lo) | (f2bf(hi) << 16); }
__device__ __forceinline__ void tr_item(const float* __restrict__ W, int K, int N, const float* __restrict__ gain, bf16_t* WT, int nblk2  , int mode, LAS bf16_t* scr, int item, int lane) {
    const int kb = item / nblk2, nb2 = item - kb * nblk2, k0 = 64 * kb;
    const int blk = (lane >> 3) & 1, n4 = (lane & 7) * 4, kr0 = lane >> 4;
    const int sc = srccol(mode, 2 * nb2 + blk);
    f32x4 v[16];
    const float* src = W + (size_t)(k0 + kr0) * N + (sc >= 0 ? sc : 0) + n4;
#pragma unroll
    for (int i = 0; i < 16; ++i) v[i] = __builtin_nontemporal_load((const f32x4*)(src + (size_t)(4 * i) * N));
    if (gain) {
#pragma unroll
        for (int i = 0; i < 16; ++i) v[i] = v[i] * gain[k0 + kr0 + 4 * i];
    }
    if (sc < 0) {
#pragma unroll
        for (int i = 0; i < 16; ++i) v[i] = (f32x4){0.f, 0.f, 0.f, 0.f};
    }
    LAS bf16_t* d = scr + (32 * blk + n4) * 66 + kr0;
#pragma unroll
    for (int i = 0; i < 16; ++i) {
        const unsigned p01 = cvt_pk_bf16(v[i][0], v[i][1]), p23 = cvt_pk_bf16(v[i][2], v[i][3]);
        d[0 * 66 + 4 * i] = (bf16_t)(p01 & 0xffffu); d[1 * 66 + 4 * i] = (bf16_t)(p01 >> 16);
        d[2 * 66 + 4 * i] = (bf16_t)(p23 & 0xffffu); d[3 * 66 + 4 * i] = (bf16_t)(p23 >> 16);
    }
    asm volatile("s_waitcnt lgkmcnt(0)" ::: "memory");
    const int c = lane & 7;
#pragma unroll
    for (int j = 0; j < 8; ++j) { const int n = (lane >> 3) + 8 * j; const LAS unsigned* sp = (const LAS unsigned*)(scr + n * 66 + 8 * c);
        u32x4 o; o.x = sp[0]; o.y = sp[1]; o.z = sp[2]; o.w = sp[3];
        *(u32x4*)(WT + (size_t)(64 * nb2 + n) * K + k0 + 8 * c) = o; }
    asm volatile("s_waitcnt lgkmcnt(0)" ::: "memory");
}
template <int MODE>
__device__ __forceinline__ void row_phase(const float* x32, bf16_t* xb, const bf16_t* f, const float* g, float c, float* rstd, float* out32) {
    const int tid = otid(), lane = tid & 63, gw = blockIdx.x * 8 + __builtin_amdgcn_readfirstlane(tid >> 6), ngw = gridDim.x * 8;
    for (int m = gw; m < M_TOK; m += ngw) {
        float xv[4][8];
        const size_t ro = (size_t)m * DM + 8 * lane;
        if (MODE == 0) {
#pragma unroll
            for (int j = 0; j < 4; ++j) { const f32x4 a = __builtin_nontemporal_load((const f32x4*)(x32 + ro + 512 * j)), b = __builtin_nontemporal_load((const f32x4*)(x32 + ro + 512 * j + 4));
#pragma unroll
                for (int e = 0; e < 4; ++e) { xv[j][e] = a[e]; xv[j][4 + e] = b[e]; } }
        } else {
            u32x4 xr[4], fr_[4];
#pragma unroll
            for (int j = 0; j < 4; ++j) { xr[j] = *(const u32x4*)(xb + ro + 512 * j); fr_[j] = *(const u32x4*)(f + ro + 512 * j); }
            float fv[4][8]; float s = 0.f;
#pragma unroll
            for (int j = 0; j < 4; ++j)
#pragma unroll
                for (int q = 0; q < 4; ++q) { const unsigned fu = fr_[j][q], xu = xr[j][q];
                    fv[j][2 * q] = __uint_as_float(fu << 16); fv[j][2 * q + 1] = __uint_as_float(fu & 0xffff0000u);
                    xv[j][2 * q] = __uint_as_float(xu << 16); xv[j][2 * q + 1] = __uint_as_float(xu & 0xffff0000u);
                    s += fv[j][2 * q] * fv[j][2 * q] + fv[j][2 * q + 1] * fv[j][2 * q + 1]; }
            s = wave_sum(s); const float rs = rsqrtf(s * (1.0f / DM) + EPS) * c;
#pragma unroll
            for (int j = 0; j < 4; ++j) { const f32x4 g0 = *(const f32x4*)(g + 8 * lane + 512 * j), g1 = *(const f32x4*)(g + 8 * lane + 512 * j + 4);
#pragma unroll
                for (int e = 0; e < 4; ++e) { xv[j][e] += fv[j][e] * g0[e] * rs; xv[j][4 + e] += fv[j][4 + e] * g1[e] * rs; } }
        }
        if (MODE == 2) {
#pragma unroll
            for (int j = 0; j < 4; ++j) { *(f32x4*)(out32 + ro + 512 * j) = (f32x4){xv[j][0], xv[j][1], xv[j][2], xv[j][3]}; *(f32x4*)(out32 + ro + 512 * j + 4) = (f32x4){xv[j][4], xv[j][5], xv[j][6], xv[j][7]}; }
        } else {
            float s2 = 0.f;
#pragma unroll
            for (int j = 0; j < 4; ++j)
#pragma unroll
                for (int e = 0; e < 8; ++e) s2 += xv[j][e] * xv[j][e];
            s2 = wave_sum(s2);
            if (lane == 0) rstd[m] = rsqrtf(s2 * (1.0f / DM) + EPS);
#pragma unroll
            for (int j = 0; j < 4; ++j) { u32x4 w; w.x = cvt_pk_bf16(xv[j][0], xv[j][1]); w.y = cvt_pk_bf16(xv[j][2], xv[j][3]); w.z = cvt_pk_bf16(xv[j][4], xv[j][5]); w.w = cvt_pk_bf16(xv[j][6], xv[j][7]);
                *(u32x4*)(xb + ro + 512 * j) = w; }
        }
    }
}
__device__ __forceinline__ float bf2f(bf16_t v) { return __uint_as_float((unsigned)v << 16); }
__device__ __forceinline__ void conv_phase(LAS unsigned char* lds, const bf16_t* glu, const float* wdw, const float* bdw, const float* gln, const float* bln, bf16_t* cv, int blk, int nblk) {
    const int tid = otid();
    LAS bf16_t* gs = (LAS bf16_t*)lds;
    LAS float* ys = (LAS float*)(lds + 64 * 1024);
    LAS float* stat = (LAS float*)(lds + 48 * 1024 + 1024);
    const int c = tid;
    float w[31];
#pragma unroll
    for (int i = 0; i < 31; ++i) w[i] = wdw[i * 512 + c];
    const float bd = bdw[c], gl = gln[c], bl = bln[c];
    const bool bal = (nblk == 256); const int nu = bal ? (blk < 128 ? 3 : 5) : (M_TOK / 16 - blk + nblk - 1) / nblk;
    for (int ui = 0; ui < nu; ++ui) {
        const int unit = bal ? (blk < 128 ? blk + 128 * ui : 384 + (blk - 128) + 128 * ui) : blk + ui * nblk;
        const int tok0 = unit * 16, t0 = tok0 & (SEQ - 1);
        for (int idx = tid; idx < 46 * 64; idx += 512) { const int row = idx >> 6, ch = idx & 63; u32x4 v = (u32x4){0u, 0u, 0u, 0u};
            if (t0 - 30 + row >= 0) v = *(const u32x4*)(glu + (size_t)(tok0 - 30 + row) * 512 + ch * 8);
            *(LAS u32x4*)(gs + row * 512 + ch * 8) = v; }
        __syncthreads();
        float y[16];
#pragma unroll
        for (int t = 0; t < 16; ++t) y[t] = bd;
#pragma unroll
        for (int rr = 0; rr < 46; ++rr) { const float gval = bf2f(gs[rr * 512 + c]);
#pragma unroll
            for (int t = 0; t < 16; ++t) { if (rr - t >= 0 && rr - t <= 30) y[t] += gval * w[rr - t]; } }
#pragma unroll
        for (int t = 0; t < 16; ++t) ys[t * 512 + c] = y[t];
        __syncthreads();
        { const int t2 = tid >> 5, p = tid & 31; float sm = 0.f, sq = 0.f;
#pragma unroll
          for (int i = 0; i < 16; ++i) { const float v = ys[t2 * 512 + p + 32 * i]; sm += v; sq += v * v; }
#pragma unroll
          for (int o = 1; o < 32; o <<= 1) { sm += __shfl_xor(sm, o); sq += __shfl_xor(sq, o); }
          if (p == 0) { const float mean = sm * (1.0f / 512.0f), var = fmaxf(sq * (1.0f / 512.0f) - mean * mean, 0.f); stat[t2 * 2] = mean; stat[t2 * 2 + 1] = rsqrtf(var + EPS); } }
        __syncthreads();
#pragma unroll
        for (int t = 0; t < 16; ++t) { const float v = (y[t] - stat[t * 2]) * stat[t * 2 + 1] * gl + bl; cv[(size_t)(tok0 + t) * 512 + c] = (bf16_t)f2bf(v * sigmoidf_(v)); }
        __syncthreads();
    }
}

#define XB_TMO      128
#define XB_XCNT(j)  (256  + 64 * (j))
#define XB_XSUB(j)  (1280 + 64 * (j))
#define XB_XGEN(j)  (2304 + 64 * (j))
#define XB_TOP      3328
#define XB_TOPGEN   3392
#define XCD_BAR_WORDS 3456
#define XB_SPIN_CAP (1u << 18)

__device__ __forceinline__ unsigned xb_ld(unsigned* p)              { return __hip_atomic_load(p, __ATOMIC_RELAXED, __HIP_MEMORY_SCOPE_AGENT); }
__device__ __forceinline__ unsigned xb_add(unsigned* p, unsigned v) { return __hip_atomic_fetch_add(p, v, __ATOMIC_RELAXED, __HIP_MEMORY_SCOPE_AGENT); }
__device__ __forceinline__ unsigned xb_xcc_id() { return (unsigned)__builtin_amdgcn_s_getreg((3 << 11) | 20) & 0xFu; }
#define XB_SPIN(cond, bar) do { unsigned _sp = 0; while (cond) { __builtin_amdgcn_s_sleep(1); \
    if ((++_sp & 255u) == 0u) { if (xb_ld(&(bar)[XB_TMO])) break; if (_sp > XB_SPIN_CAP) { atomicAdd(&(bar)[XB_TMO], 1u); break; } } } } while (0)

struct XcdBarrier {
    unsigned* bar; unsigned x;
    volatile LAS unsigned* st;
};

__device__ __forceinline__ XcdBarrier xcd_barrier_post(unsigned* bar, volatile LAS unsigned* st) {
    XcdBarrier b; b.bar = bar; b.x = xb_xcc_id(); b.st = st;
    if (threadIdx.x == 0) (void)xb_add(&bar[XB_XCNT(b.x)], 1u);
    return b;
}
__device__ __forceinline__ void xcd_barrier_complete(unsigned* bar, unsigned x, unsigned& nloc, unsigned& nx) {
    const unsigned G = gridDim.x * gridDim.y * gridDim.z;
    unsigned sum, cnt, mine, sp = 0u;
    for (;;) {
        sum = 0u; cnt = 0u; mine = 0u;
#pragma unroll
        for (unsigned j = 0; j < 16; ++j) { const unsigned c = xb_ld(&bar[XB_XCNT(j)]); sum += c; cnt += (c > 0u) ? 1u : 0u; mine = (j == x) ? c : mine; }
        if (sum == G) break;
        __builtin_amdgcn_s_sleep(1);
        if ((++sp & 255u) == 0u) { if (xb_ld(&bar[XB_TMO])) break; if (sp > XB_SPIN_CAP) { atomicAdd(&bar[XB_TMO], 1u); break; } }
    }
    nloc = mine > 0u ? mine : 1u; nx = cnt > 0u ? cnt : 1u;
}

__device__ __forceinline__ void xcd_barrier(const XcdBarrier& b) {
    asm volatile("s_waitcnt vmcnt(0)" ::: "memory");
    __syncthreads();
    if (threadIdx.x == 0) {
        unsigned* bar = b.bar;
        __builtin_amdgcn_s_waitcnt(0);
        unsigned nloc = b.st[0], nx = b.st[1];
        if (nloc == 0u) { xcd_barrier_complete(bar, b.x, nloc, nx); b.st[0] = nloc; b.st[1] = nx; }
        const unsigned old = xb_add(&bar[XB_XSUB(b.x)], 1u);
        const unsigned gen = old / nloc;
        if (old + 1u == (gen + 1u) * nloc) {
            __builtin_amdgcn_fence(__ATOMIC_RELEASE, "agent");
            asm volatile("s_waitcnt vmcnt(0)" ::: "memory");
            const unsigned og = xb_add(&bar[XB_TOP], 1u);
            const unsigned tg = og / nx;
            if (og + 1u == (tg + 1u) * nx) xb_add(&bar[XB_TOPGEN], 1u);
            else XB_SPIN(xb_ld(&bar[XB_TOPGEN]) == tg, bar);
            __builtin_amdgcn_fence(__ATOMIC_ACQUIRE, "agent");
            xb_add(&bar[XB_XGEN(b.x)], 1u);
            asm volatile("s_waitcnt vmcnt(0)" ::: "memory");
        } else {
            XB_SPIN(xb_ld(&bar[XB_XGEN(b.x)]) == gen, bar);
            __builtin_amdgcn_fence(__ATOMIC_ACQUIRE, "agent");
            asm volatile("s_waitcnt vmcnt(0)" ::: "memory");
        }
    }
    __syncthreads();
}

#ifndef PHMASK
#define PHMASK 0xffff
#endif
#define PH_ON(k) (((PHMASK) >> (k)) & 1)
#ifndef REP_P0
#define REP_P0 1
#endif
#ifndef REP_FFN
#define REP_FFN 1
#endif
#ifndef REP_ATT
#define REP_ATT 1
#endif
#ifndef REP_ROW
#define REP_ROW 1
#endif
struct Params { const float* in[28]; float* out; unsigned char* ws; };
static_assert(sizeof(Params) == 30 * 8, "no padding");
typedef pg8::StaticOrder SO;
#define GEMM_RUN(EPI_T, epi, Aptr, Bptr, Nn, Kk) GEMM_RUN_G(EPI_T, epi, Aptr, Bptr, Nn, Kk, G, bx)
#define GEMM_RUN_G(EPI_T, epi, Aptr, Bptr, Nn, Kk, GG, CC) do { int kk_ = (Kk); asm volatile("" : "+s"(kk_));     \
        pg8::Gemm g_{(const bf16_t*)(Aptr), (const bf16_t*)(Bptr), M_TOK, (Nn), kk_}; SO S_; S_.init(M_TOK, (Nn), (GG), (CC)); \
        pg8::gemm_phase<EPI_T, SO, true, true>(lds, g_, S_, (epi)); } while (0)

__device__ __forceinline__ unsigned char* ows(unsigned char* p) { __attribute__((address_space(1))) unsigned char* g = (__attribute__((address_space(1))) unsigned char*)p; asm volatile("" : "+s"(g)); return (unsigned char*)g; }
#define BF(off) ((bf16_t*)(wsp + (off)))
#define FP(off) ((float*)(wsp + (off)))
__global__ void __launch_bounds__(512) mega_fwd(Params P) {
    extern __shared__ __attribute__((aligned(16))) unsigned char lds_raw[];
    LAS unsigned char* lds = (LAS unsigned char*)lds_raw;
    cg::grid_group grid = cg::this_grid();
    const int G = gridDim.x, bx = blockIdx.x;
    if (threadIdx.x < 64) ((LAS unsigned*)(lds + MISC_OFF))[threadIdx.x] = 0u;
    __syncthreads();
    const XcdBarrier bar = xcd_barrier_post((unsigned*)P.ws + CW_BAR, (volatile LAS unsigned*)(lds + MISC_OFF + 64));
    if (P.ws == nullptr) grid.sync();
#define SEAM() do { XcdBarrier b_ = bar; asm volatile("" : "+s"(b_.bar), "+s"(b_.x)); xcd_barrier(b_); } while (0)

    for (int rep0 = 0; rep0 < REP_P0; ++rep0) {
        unsigned char* wsp = ows(P.ws);
        const int tid = otid(), lane = tid & 63, wid = __builtin_amdgcn_readfirstlane(tid >> 6), gw = bx * 8 + wid, ngw = G * 8;
        LAS bf16_t* scr = (LAS bf16_t*)(lds + wid * 16384);
        constexpr int I1 = 5632, I2 = 2816, I3 = 1792, I4 = 192, I5 = 128, I6 = 64, I7 = 1024, I10 = 1024, I11 = 128;
        constexpr int IL = I1 + I2 + I3 + I4 + I5 + I6 + I7 + I1 + I2 + I10 + I11;
        for (int it = gw; it < 2 * IL; it += ngw) {
            const int L = it >= IL ? 1 : 0; int r = it - L * IL;
            unsigned char* wl = wsp + WS_W + (size_t)L * W_LAYER;
            if (r < I1) { tr_item(P.in[4] + (size_t)L * DM * 2 * DFF, DM, 2 * DFF, P.in[3] + L * DM, (bf16_t*)(wl + WO_FF1IN), 176, 1, scr, r, lane); continue; } r -= I1;
            if (r < I2) { tr_item(P.in[5] + (size_t)L * DFF * DM, DFF, DM, nullptr, (bf16_t*)(wl + WO_FF1OUT), 32, 0, scr, r, lane); continue; } r -= I2;
            if (r < I3) { tr_item(P.in[8] + (size_t)L * DM * 3392, DM, 3392, P.in[7] + L * DM, (bf16_t*)(wl + WO_IN), 56, 2, scr, r, lane); continue; } r -= I3;
            if (r < I4) { tr_item(P.in[10] + (size_t)L * 512 * 1536, 512, 1536, P.in[9] + L * 512, (bf16_t*)(wl + WO_UQ), 24, 3, scr, r, lane); continue; } r -= I4;
            if (r < I5) { tr_item(P.in[12] + (size_t)L * 256 * 2048, 256, 2048, P.in[11] + L * 256, (bf16_t*)(wl + WO_UKV), 32, 0, scr, r, lane); continue; } r -= I5;
            if (r < I6) { tr_item(P.in[17] + (size_t)L * 512 * 512, 512, 512, nullptr, (bf16_t*)(wl + WO_PW), 8, 0, scr, r, lane); continue; } r -= I6;
            if (r < I7) { tr_item(P.in[18] + (size_t)L * DM * DM, DM, DM, nullptr, (bf16_t*)(wl + WO_OUT), 32, 0, scr, r, lane); continue; } r -= I7;
            if (r < I1) { tr_item(P.in[21] + (size_t)L * DM * 2 * DFF, DM, 2 * DFF, P.in[20] + L * DM, (bf16_t*)(wl + WO_FF2IN), 176, 1, scr, r, lane); continue; } r -= I1;
            if (r < I2) { tr_item(P.in[22] + (size_t)L * DFF * DM, DFF, DM, nullptr, (bf16_t*)(wl + WO_FF2OUT), 32, 0, scr, r, lane); continue; } r -= I2;
            if (r < I10) { tr_item(P.in[25] + (size_t)L * DM * DM, DM, DM, P.in[24] + L * DM, (bf16_t*)(wl + WO_GATE), 32, 0, scr, r, lane); continue; } r -= I10;
            tr_item(P.in[26] + (size_t)L * 256 * DM, 256, DM, nullptr, (bf16_t*)(wl + WO_PROJ), 32, 0, scr, r, lane);
        }
        const int gt = bx * 512 + tid, ngt = G * 512;
        for (int i = gt; i < 2 * M_TOK * 256 / 4; i += ngt) { const f32x4 v = ((const f32x4*)P.in[1])[i]; u32x2 w; w.x = cvt_pk_bf16(v[0], v[1]); w.y = cvt_pk_bf16(v[2], v[3]); ((u32x2*)BF(WS_PB))[i] = w; }
        const int* pos = (const int*)P.in[2];
        for (int i = gt; i < M_TOK * 32; i += ngt) { const int tok = i >> 5, j = i & 31;
            const float inv = exp2f(-(float)j * (13.287712379549449f / 32.0f));
            const float ang = (float)pos[tok] * inv;
            double rev = (double)ang * 0.15915494309189535; rev -= floor(rev);
            FP(WS_COS)[i] = __builtin_amdgcn_cosf((float)rev); FP(WS_SIN)[i] = __builtin_amdgcn_sinf((float)rev); }
        row_phase<0>(P.in[0], BF(WS_XN), nullptr, nullptr, 0.f, FP(WS_RSTD), nullptr);
    }
    SEAM();

    for (int L = 0; L < 2; ++L) {
        for (int rf = 0; rf < REP_FFN; ++rf) { unsigned char* wsp = ows(P.ws); unsigned char* wl = wsp + WS_W + (size_t)L * W_LAYER; EpiSwiglu E{BF(WS_HID), FP(WS_RSTD)}; GEMM_RUN(EpiSwiglu, E, BF(WS_XN), wl + WO_FF1IN, 2 * DFF, DM); }
        SEAM();
        for (int rf = 0; rf < REP_FFN; ++rf) { unsigned char* wsp = ows(P.ws); unsigned char* wl = wsp + WS_W + (size_t)L * W_LAYER; EpiBf E{BF(WS_F), DM}; GEMM_RUN(EpiBf, E, BF(WS_HID), wl + WO_FF1OUT, DM, DFF); }
        SEAM();
        if (PH_ON(3)) { unsigned char* wsp = ows(P.ws); row_phase<1>(nullptr, BF(WS_XN), BF(WS_F), P.in[6] + L * DM, 0.5f, FP(WS_RSTD), nullptr); }
        SEAM();
        if (PH_ON(4)) { unsigned char* wsp = ows(P.ws); unsigned char* wl = wsp + WS_W + (size_t)L * W_LAYER; EpiWin E{wsp}; GEMM_RUN(EpiWin, E, BF(WS_XN), wl + WO_IN, NWIN, DM);
            if (PH_ON(11) && G == 256 && bx >= 128) { EpiBf E2{BF(WS_EB), DM}; GEMM_RUN_G(EpiBf, E2, BF(WS_PB) + (size_t)L * M_TOK * 256, wl + WO_PROJ, DM, 256, 128, bx - 128); } }
        SEAM();
        if (PH_ON(5)) { unsigned char* wsp = ows(P.ws); conv_phase(lds, BF(WS_GLU), P.in[13] + L * 31 * 512, P.in[14] + L * 512, P.in[15] + L * 512, P.in[16] + L * 512, BF(WS_CV), bx, G); }
        if (PH_ON(6)) { unsigned char* wsp = ows(P.ws); unsigned char* wl = wsp + WS_W + (size_t)L * W_LAYER; EpiUq E{BF(WS_Q), FP(WS_SSQ), FP(WS_COS), FP(WS_SIN)}; GEMM_RUN(EpiUq, E, BF(WS_CQ), wl + WO_UQ, 1536, 512); }
        if (PH_ON(7)) { unsigned char* wsp = ows(P.ws); unsigned char* wl = wsp + WS_W + (size_t)L * W_LAYER; EpiUkv E{BF(WS_KN), BF(WS_V), FP(WS_SSQ)}; GEMM_RUN(EpiUkv, E, BF(WS_CKV), wl + WO_UKV, 2048, 256); }
        SEAM();
        if (PH_ON(8)) { unsigned char* wsp = ows(P.ws); unsigned char* wl = wsp + WS_W + (size_t)L * W_LAYER; EpiBf E{BF(WS_MIX) + 1024, DM}; GEMM_RUN(EpiBf, E, BF(WS_CV), wl + WO_PW, 512, 512); }
        if (PH_ON(9) || PH_ON(10)) {
            unsigned char* wsp = ows(P.ws);
            LAS int* slot = (LAS int*)(lds + MISC_OFF);
            const int tid = otid();
            for (;;) {
                __syncthreads();
                const int nq = G == 256 ? 96 : 768;
                if (tid == 0) {
                    int xs = G == 256 ? (bx & 7) : 0, got = -1;
                    for (int k = 0; k < (G == 256 ? 8 : 1); ++k) {
                        const int i_ = (int)atomicAdd((unsigned*)wsp + 64 * (L * 8 + xs), 1u);
                        if (i_ < nq) { got = i_; break; }
                        xs = (xs + 1) & 7;
                    }
                    slot[0] = got; slot[1] = xs;
                }
                __syncthreads();
                const int it = __builtin_amdgcn_readfirstlane(slot[0]), xq = __builtin_amdgcn_readfirstlane(slot[1]);
                if (it < 0) break;
                int qblk, r; bool sb;
                if (G == 256) { const int lvl = it / 6; r = it - lvl * 6; qblk = 15 - lvl; sb = r < 2; r = sb ? 2 * xq + r : 4 * xq + (r - 2); }
                else { const int lvl = it / 48; r = it - lvl * 48; qblk = 15 - lvl; sb = r < 16; r = sb ? r : r - 16; }
                const bool prb = false;
                if (sb) { if (PH_ON(9)) { const int b = r >> 2, h = r & 3;
                    att::attn_unit<true>(lds, BF(WS_SBQ) + h * 128, 512, BF(WS_SBK) + h * 128, 512, BF(WS_SBV) + h * 128, 512, nullptr, BF(WS_MIX) + 1536 + h * 128, b * SEQ, qblk); }
                } else if (PH_ON(10)) { const int b = r >> 3, h = r & 7;
                    att::attn_unit<false>(lds, BF(WS_Q) + h * 192, 1536, BF(WS_KN) + h * 128, 1024, BF(WS_V) + h * 128, 1024, BF(WS_KR), BF(WS_MIX) + h * 128, b * SEQ, qblk); }
            }
        }
        SEAM();
        if (PH_ON(2)) { unsigned char* wsp = ows(P.ws); unsigned char* wl = wsp + WS_W + (size_t)L * W_LAYER; EpiBf E{BF(WS_F), DM}; GEMM_RUN(EpiBf, E, BF(WS_MIX), wl + WO_OUT, DM, DM); }
        SEAM();
        if (PH_ON(3)) { unsigned char* wsp = ows(P.ws); row_phase<1>(nullptr, BF(WS_XN), BF(WS_F), P.in[19] + L * DM, 1.0f, FP(WS_RSTD), nullptr); }
        SEAM();
        for (int rf = 0; rf < REP_FFN; ++rf) { unsigned char* wsp = ows(P.ws); unsigned char* wl = wsp + WS_W + (size_t)L * W_LAYER; EpiSwiglu E{BF(WS_HID), FP(WS_RSTD)}; GEMM_RUN(EpiSwiglu, E, BF(WS_XN), wl + WO_FF2IN, 2 * DFF, DM); }
        SEAM();
        for (int rf = 0; rf < REP_FFN; ++rf) { unsigned char* wsp = ows(P.ws); unsigned char* wl = wsp + WS_W + (size_t)L * W_LAYER; EpiBf E{BF(WS_F), DM}; GEMM_RUN(EpiBf, E, BF(WS_HID), wl + WO_FF2OUT, DM, DFF); }
        SEAM();
        if (PH_ON(3)) { unsigned char* wsp = ows(P.ws); row_phase<1>(nullptr, BF(WS_XN), BF(WS_F), P.in[23] + L * DM, 0.5f, FP(WS_RSTD), nullptr); }
        SEAM();
        if (PH_ON(11) && G != 256) { unsigned char* wsp = ows(P.ws); unsigned char* wl = wsp + WS_W + (size_t)L * W_LAYER; EpiBf E{BF(WS_EB), DM}; GEMM_RUN(EpiBf, E, BF(WS_PB) + (size_t)L * M_TOK * 256, wl + WO_PROJ, DM, 256); SEAM(); }
        if (PH_ON(12)) { unsigned char* wsp = ows(P.ws); unsigned char* wl = wsp + WS_W + (size_t)L * W_LAYER; EpiGate E{BF(WS_F), BF(WS_EB), FP(WS_RSTD)}; GEMM_RUN(EpiGate, E, BF(WS_XN), wl + WO_GATE, DM, DM); }
        SEAM();
        if (PH_ON(3)) { unsigned char* wsp = ows(P.ws);
            if (L == 0) row_phase<1>(nullptr, BF(WS_XN), BF(WS_F), P.in[27] + L * DM, 1.0f, FP(WS_RSTD), nullptr);
            else row_phase<2>(nullptr, BF(WS_XN), BF(WS_F), P.in[27] + L * DM, 1.0f, nullptr, P.out); }
        if (L == 0) SEAM();
    }
}

extern "C" void kernel_launch(void* const* d_in, const int* in_sizes, int n_in, void* d_out, int out_size, void* d_ws, size_t ws_size, hipStream_t stream) {
    static int grid = 0;
    if (grid == 0) {
        if (n_in != 28 || out_size != M_TOK * DM || ws_size < WS_END) { fprintf(stderr, "kernel_launch: unexpected shapes (n_in %d out %d ws %zu)\n", n_in, out_size, ws_size); grid = -1; return; }
        int dev = 0, cus = 0, per_cu = 0;
        (void)hipGetDevice(&dev); (void)hipDeviceGetAttribute(&cus, hipDeviceAttributeMultiprocessorCount, dev);
        if (hipFuncSetAttribute((const void*)mega_fwd, hipFuncAttributeMaxDynamicSharedMemorySize, LDS_BYTES) != hipSuccess) { fprintf(stderr, "kernel_launch: hipFuncSetAttribute failed\n"); grid = -1; return; }
        if (hipOccupancyMaxActiveBlocksPerMultiprocessor(&per_cu, (const void*)mega_fwd, 512, LDS_BYTES) != hipSuccess || per_cu < 1) { fprintf(stderr, "kernel_launch: occupancy query says %d\n", per_cu); per_cu = 1; }
        (void)hipGetLastError();
        grid = cus * 1;
    }
    if (grid < 0) return;
    if (hipMemsetAsync(d_ws, 0, 65536, stream) != hipSuccess) { fprintf(stderr, "kernel_launch: memset of the control words failed\n"); return; }
    Params p{};
    for (int i = 0; i < 28; ++i) p.in[i] = (const float*)d_in[i];
    p.out = (float*)d_out; p.ws = (unsigned char*)d_ws;
    void* args[] = {&p};
    hipError_t e = hipLaunchCooperativeKernel((const void*)mega_fwd, dim3(grid), dim3(512), args, LDS_BYTES, stream);
    if (e != hipSuccess) fprintf(stderr, "cooperative launch failed: %s (grid %d)\n", hipGetErrorString(e), grid);
}
```
